# Optimizing an MI355X kernel written in HIP

```python
import jax, jax.numpy as jnp
from jax import lax
import numpy as np

D_MODEL = 1024
BATCH = 4
SEQ = 8192
DEPTH = 1
DEC_BATCH = 16
DEC_SEQ = 16
PAST_LEN = 1024

CHUNK = 64
WINDOW = 128
W_CHUNKS = WINDOW // CHUNK
HEAD_DIM = 64
N_HEADS = D_MODEL // HEAD_DIM
N_KV_HEADS = 4
GROUP = N_HEADS // N_KV_HEADS
Q_DIM = N_HEADS * HEAD_DIM
KV_DIM = N_KV_HEADS * HEAD_DIM
D_CONV = D_MODEL
CONV_W = 3
D_FF = ((8 * D_MODEL // 3 + 255) // 256) * 256
EPS = 1e-6
NEG_INF = -1e30
SCALE = HEAD_DIM ** -0.5
SPLITS = list(np.cumsum([D_CONV, D_CONV, D_CONV, Q_DIM, KV_DIM, KV_DIM, D_MODEL]))
IN_COLS = 3 * D_CONV + Q_DIM + 2 * KV_DIM + 2 * D_MODEL

kernel_name = "hybrid_shortconv_swa_sink_stream_step"


def rms_norm(x, w):
    xf = x.astype(jnp.float32)
    y = xf * lax.rsqrt(jnp.mean(xf * xf, axis=-1, keepdims=True) + EPS)
    return (y * w.astype(jnp.float32)).astype(x.dtype)


def mixer_inputs(x, norm_w, w_in, q_norm_w, k_norm_w):
    b, t = x.shape[:2]
    xn = rms_norm(x, norm_w)
    h, gb, gc, q, k, v, g_conv, g_attn = jnp.split(xn @ w_in, SPLITS, axis=-1)
    q = rms_norm(q.reshape(b, t, N_KV_HEADS, GROUP, HEAD_DIM), q_norm_w)
    k = rms_norm(k.reshape(b, t, N_KV_HEADS, HEAD_DIM), k_norm_w)
    v = v.reshape(b, t, N_KV_HEADS, HEAD_DIM)
    u = gc * h
    return u, gb, q, k, v, g_conv, g_attn


def causal_conv(u, prefix, w):
    t = u.shape[1]
    up = jnp.concatenate([prefix, u], axis=1)
    y = w[0] * up[:, 0:t] + w[1] * up[:, 1:t + 1] + w[2] * up[:, 2:t + 2]
    return y, up[:, -(CONV_W - 1):]


def sink_attention(q, k, v, valid, sinks):
    s = jnp.einsum('bcqhgd,bckhd->bchgqk', q, k).astype(jnp.float32) * SCALE
    s = jnp.where(valid, s, NEG_INF)
    sink = jnp.broadcast_to(sinks.astype(jnp.float32).reshape(N_KV_HEADS, GROUP)[None, None, :, :, None, None],
                            s.shape[:-1] + (1,))
    p = jax.nn.softmax(jnp.concatenate([s, sink], axis=-1), axis=-1)[..., :-1]
    return jnp.einsum('bchgqk,bckhd->bcqhgd', p.astype(v.dtype), v)


def window_attention_prompt(q, k, v, sinks):
    b, t = q.shape[:2]
    nc = t // CHUNK
    qc = q.reshape(b, nc, CHUNK, N_KV_HEADS, GROUP, HEAD_DIM)

    def band(a):
        ac = a.reshape(b, nc, CHUNK, N_KV_HEADS, HEAD_DIM)
        ap = jnp.pad(ac, ((0, 0), (W_CHUNKS, 0), (0, 0), (0, 0), (0, 0)))
        return jnp.concatenate([ap[:, j:j + nc] for j in range(W_CHUNKS + 1)], axis=2)

    kb, vb = band(k), band(v)
    chunk_idx = jnp.arange(nc)[:, None]
    src_off = jnp.repeat(jnp.arange(W_CHUNKS + 1), CHUNK)[None, :]
    valid = (chunk_idx + src_off - W_CHUNKS >= 0)[None, :, None, None, None, :]
    o = sink_attention(qc, kb, vb, valid, sinks)
    return o.reshape(b, t, Q_DIM)


def window_attention_sample(q, k, v, cache_k, cache_v, sinks):
    b, t = q.shape[:2]
    kk = jnp.concatenate([cache_k, k], axis=1)[:, None]
    vv = jnp.concatenate([cache_v, v], axis=1)[:, None]
    o = sink_attention(q[:, None], kk, vv, jnp.ones((), dtype=bool), sinks)
    return o[:, 0].reshape(b, t, Q_DIM)


def block_output(x, y_conv, y_attn, g_conv, g_attn, w_out, norm_ffn_w, w_gate, w_up, w_down):
    merged = jax.nn.sigmoid(g_conv) * y_conv + jax.nn.sigmoid(g_attn) * y_attn
    x = x + merged @ w_out
    xn = rms_norm(x, norm_ffn_w)
    return x + (jax.nn.silu(xn @ w_gate) * (xn @ w_up)) @ w_down


def setup_inputs(seed: int = 0) -> dict:
    key = jax.random.key(seed)
    ks = jax.random.split(key, 18)
    f32 = jnp.float32
    cache_len = min(WINDOW, PAST_LEN)
    nrm = lambda k, shape, s: jax.random.normal(k, shape, f32) * s
    return {
        "x_prompt": nrm(ks[0], (BATCH, SEQ, D_MODEL), 1.0),
        "x_sample": nrm(ks[1], (DEC_BATCH, DEC_SEQ, D_MODEL), 1.0),
        "state_conv": nrm(ks[2], (DEPTH, DEC_BATCH, CONV_W - 1, D_CONV), 1.0),
        "cache_k": nrm(ks[3], (DEPTH, DEC_BATCH, cache_len, N_KV_HEADS, HEAD_DIM), 1.0),
        "cache_v": nrm(ks[4], (DEPTH, DEC_BATCH, cache_len, N_KV_HEADS, HEAD_DIM), 1.0),
        "norm_mix_w": 1.0 + nrm(ks[5], (DEPTH, D_MODEL), 0.02),
        "w_in": nrm(ks[6], (DEPTH, D_MODEL, IN_COLS), D_MODEL ** -0.5),
        "conv_w": nrm(ks[7], (DEPTH, CONV_W, D_CONV), CONV_W ** -0.5),
        "q_norm_w": 1.0 + nrm(ks[8], (DEPTH, HEAD_DIM), 0.02),
        "k_norm_w": 1.0 + nrm(ks[9], (DEPTH, HEAD_DIM), 0.02),
        "sinks": nrm(ks[10], (DEPTH, N_HEADS), 0.5),
        "w_out": nrm(ks[11], (DEPTH, D_MODEL, D_MODEL), D_MODEL ** -0.5),
        "norm_ffn_w": 1.0 + nrm(ks[12], (DEPTH, D_MODEL), 0.02),
        "w_gate": nrm(ks[13], (DEPTH, D_MODEL, D_FF), D_MODEL ** -0.5),
        "w_up": nrm(ks[14], (DEPTH, D_MODEL, D_FF), D_MODEL ** -0.5),
        "w_down": nrm(ks[15], (DEPTH, D_FF, D_MODEL), D_FF ** -0.5),
    }


def reference(x_prompt, x_sample, state_conv, cache_k, cache_v, norm_mix_w, w_in, conv_w,
              q_norm_w, k_norm_w, sinks, w_out, norm_ffn_w, w_gate, w_up, w_down):
    yp, ys = x_prompt, x_sample
    conv_p, k_p, v_p, conv_s, k_s, v_s = [], [], [], [], [], []
    for l in range(DEPTH):
        u, gb, q, k, v, g_c, g_a = mixer_inputs(yp, norm_mix_w[l], w_in[l], q_norm_w[l], k_norm_w[l])
        zero_prefix = jnp.zeros((u.shape[0], CONV_W - 1, D_CONV), u.dtype)
        cy, ctail = causal_conv(u, zero_prefix, conv_w[l])
        ay = window_attention_prompt(q, k, v, sinks[l])
        yp = block_output(yp, gb * cy, ay, g_c, g_a, w_out[l], norm_ffn_w[l], w_gate[l], w_up[l], w_down[l])
        conv_p.append(ctail)
        k_p.append(k[:, -WINDOW:])
        v_p.append(v[:, -WINDOW:])
        u, gb, q, k, v, g_c, g_a = mixer_inputs(ys, norm_mix_w[l], w_in[l], q_norm_w[l], k_norm_w[l])
        cy, ctail = causal_conv(u, state_conv[l].astype(u.dtype), conv_w[l])
        ay = window_attention_sample(q, k, v, cache_k[l].astype(k.dtype), cache_v[l].astype(v.dtype), sinks[l])
        ys = block_output(ys, gb * cy, ay, g_c, g_a, w_out[l], norm_ffn_w[l], w_gate[l], w_up[l], w_down[l])
        conv_s.append(ctail)
        k_s.append(k)
        v_s.append(v)
    return (yp, ys, jnp.stack(conv_p), jnp.stack(k_p), jnp.stack(v_p),
            jnp.stack(conv_s), jnp.stack(k_s), jnp.stack(v_s))
```

```cpp
#include <hip/hip_runtime.h>
#include <cstdio>
#include <cstdint>
namespace pg8 {
#define PG8_LAS __attribute__((address_space(3)))
typedef unsigned short bf16_t;
typedef short bf16x8 __attribute__((ext_vector_type(8)));
typedef float f32x4 __attribute__((ext_vector_type(4)));
typedef unsigned u32x4 __attribute__((ext_vector_type(4)));
constexpr int BM = 256, BK = 64, HALF = 128, HTB = HALF * BK * 2  , STAGE_BYTES = 8 * HTB, NXCD = 8, WGM = 8;

__host__ __device__ __forceinline__ int lds_byte(int r, int c) { const int st = (r >> 4) * 2 + (c >> 5), rr = r & 15, cc = c & 31, ob = rr * 64 + cc * 2; return st * 1024 + (ob ^ (((ob >> 9) & 1) << 5)); }
__host__ __device__ __forceinline__ void stage_rc(int b, int& R, int& C) { const int st = b / 1024, sb = b % 1024, swz = sb ^ (((sb >> 9) & 1) << 5); R = (st >> 1) * 16 + swz / 64; C = (st & 1) * 32 + (swz % 64) / 2; }
__host__ __device__ __forceinline__ int perm32(int rho) { const int n = rho >> 4, i = rho & 15; return 8 * (i >> 2) + 4 * n + (i & 3); }

struct Unit { int pm, pn; };
struct Gemm { const bf16_t* A; const bf16_t* Bt; int M, N, K; };

struct StaticOrder {
    int nM, nN, nwg, G, c;
    __host__ __device__ void init(int M, int N, int G_, int c_) { nM = M / BM; nN = N / BM; nwg = nM * nN; G = G_; c = c_; }
    __host__ __device__ bool next(int i, Unit& u) const {
        const long L = (long)i * G + c; if (L >= nwg) return false;
        int wgid = (int)L; { const int q = nwg / NXCD, r = nwg % NXCD, xcd = wgid % NXCD, off = wgid / NXCD; wgid = (xcd < r ? xcd * (q + 1) : r * (q + 1) + (xcd - r) * q) + off; }
        const int nig = WGM * nN, gid = wgid / nig, fm = gid * WGM, gsz = (nM - fm) < WGM ? (nM - fm) : WGM;
        u.pm = fm + ((wgid % nig) % gsz); u.pn = (wgid % nig) / gsz; return true;
    }
    __device__ __forceinline__ void a_ready(const Unit&) const {}
    __device__ __forceinline__ void done(const Unit&) const {}
};
typedef float f32x2_t __attribute__((ext_vector_type(2))); typedef __bf16 bf16x2_t __attribute__((ext_vector_type(2)));
__device__ __forceinline__ unsigned cvt_pk_bf16(float lo, float hi) { f32x2_t v = {lo, hi}; bf16x2_t b = __builtin_convertvector(v, bf16x2_t); return __builtin_bit_cast(unsigned, b); }
__device__ __forceinline__ float sigmoid_f(float x) { return __builtin_amdgcn_rcpf(1.0f + __builtin_amdgcn_exp2f(-1.4426950408889634f * x)); }
__device__ __forceinline__ u32x4 pack8(const f32x4& a, const f32x4& b) { u32x4 w; w.x = cvt_pk_bf16(a[0], a[1]); w.y = cvt_pk_bf16(a[2], a[3]); w.z = cvt_pk_bf16(b[0], b[1]); w.w = cvt_pk_bf16(b[2], b[3]); return w; }

#ifndef PS_ATT
#define PS_ATT 1.0f
#define PS_CONV 1.0f
#define PS_FFN 1.0f
#endif
#ifndef PSC0
#define PSC0 1.0f
#define PSC1 1.0f
#define PSC2 1.0f
#define PSC3 1.0f
#define PSC4 1.0f
#define PSC5 1.0f
#define PSC6 1.0f
#define PSC7 1.0f
#endif
constexpr int MROWS = 33024, MP = 32768, SEQ_T = 8192;
constexpr float RMS_EPS = 1e-6f;
constexpr size_t EO_Q = 105ull << 20, EO_K = 170ull << 20, EO_V = 187ull << 20, EO_U = 204ull << 20, EO_BG = 269ull << 20, EO_SG = 334ull << 20;
constexpr float QSCALE = 0.125f * 1.4426950408889634f;
constexpr size_t OUT_Y = 0, OUT_CONVP = 33816576, OUT_KP = 33824768, OUT_VP = 33955840, OUT_CONVS = 34086912, OUT_KS = 34119680, OUT_VS = 34185216, OUT_TOTAL = 34250752;

struct EpiIn {
    static constexpr bool PERM = true, AFTER_DRAIN = false;
    unsigned char* ws; const float *qw, *kw; float* out;
    __device__ __forceinline__ void operator()(const f32x4 (&acc)[2][2][4][2], const Unit& u, int wr, int wc, int fr, int fq) const {
        asm volatile("" : "+v"(fr), "+v"(fq), "+s"(wr), "+s"(wc));
        const int pn = u.pn, pm = u.pm;
#ifdef PROBE_ACC_CHECK
        if (fr == 0 && fq == 0) {
            const bf16_t* XNp = (const bf16_t*)(ws + (40ull << 20)); const bf16_t* WTp = (const bf16_t*)(ws + (8ull << 20));
            bool bad = false;
            for (int ai = 0; ai < 2; ++ai) for (int bj = 0; bj < 2; ++bj) {
                const bf16_t* xr = XNp + ((size_t)pm * BM + 128 * ai + 64 * wr) * 1024; const bf16_t* wrw = WTp + ((size_t)pn * BM + 128 * bj + 32 * wc) * 1024;
                float a = 0.f;
                for (int k = 0; k < 1024; ++k) a += __uint_as_float((unsigned)xr[k] << 16) * __uint_as_float((unsigned)wrw[k] << 16);
                const float got = ai == 0 ? (bj == 0 ? acc[0][0][0][0][0] : acc[0][1][0][0][0]) : (bj == 0 ? acc[1][0][0][0][0] : acc[1][1][0][0][0]);
                if (!(fabsf(a - got) < 0.02f)) bad = true;
            }
            if (bad) { const int cls = pn < 8 ? 0 : (pn < 16 ? 1 : (pn < 20 ? 2 : (pn < 22 ? 4 : 3))); ((unsigned*)ws)[2048 + cls] = 1u; }
        }
#endif
        bf16_t* const U = (bf16_t*)(ws + EO_U); bf16_t* const BG = (bf16_t*)(ws + EO_BG); bf16_t* const SG = (bf16_t*)(ws + EO_SG);
        bf16_t* const Q = (bf16_t*)(ws + EO_Q); bf16_t* const K = (bf16_t*)(ws + EO_K); bf16_t* const V = (bf16_t*)(ws + EO_V);
        const int lrow0 = wr * 64 + fr;
        const size_t grow0 = (size_t)pm * BM + lrow0;
        if (pn < 16) {
            const bool isU = pn < 8; const int p = isU ? pn : pn - 8;
            bf16_t* O = isU ? U : BG;
            const int col = 128 * p + 32 * wc + 8 * fq;
#pragma unroll
            for (int ai = 0; ai < 2; ++ai)
#pragma unroll
                for (int m = 0; m < 4; ++m) {
                    f32x4 a0 = acc[ai][0][m][0], a1 = acc[ai][0][m][1], b0 = acc[ai][1][m][0], b1 = acc[ai][1][m][1];
                    f32x4 r0, r1;
                    if (isU) { r0 = a0 * b0; r1 = a1 * b1; }
                    else {
#pragma unroll
                        for (int j = 0; j < 4; ++j) { r0[j] = a0[j] * sigmoid_f(b0[j]); r1[j] = a1[j] * sigmoid_f(b1[j]); }
                    }
                    const size_t row = grow0 + ai * HALF + m * 16;
                    *(u32x4*)(O + row * 1024 + col) = pack8(r0, r1);
                    if (isU && fr >= 14) {
                        float* dst = nullptr;
                        float psc = 1.f;
                        if (pm == 128) { dst = out + OUT_CONVS + (size_t)((8 * ai + 4 * wr + m) * 2 + (fr - 14)) * 1024 + col; psc = PSC5; }
                        else if ((pm & 31) == 31 && ai == 1 && wr == 1 && m == 3) { dst = out + OUT_CONVP + (size_t)((pm >> 5) * 2 + (fr - 14)) * 1024 + col; psc = PSC2; }
                        if (dst) { *(f32x4*)dst = r0 * psc; *(f32x4*)(dst + 4) = r1 * psc; }
                    }
                }
        } else if (pn < 22) {
            const bool isQ = pn < 20, isK = pn == 20;
            const float* nw = isQ ? qw : kw; asm volatile("" : "+s"(nw));
            f32x4 w[2][2];
#pragma unroll
            for (int bj = 0; bj < 2; ++bj)
#pragma unroll
                for (int n = 0; n < 2; ++n) {
                    if (pn == 21) w[bj][n] = (f32x4){1.f, 1.f, 1.f, 1.f};
                    else { w[bj][n] = *(const __attribute__((address_space(1))) f32x4*)(nw + 32 * bj + 8 * fq + 4 * n); if (isQ) w[bj][n] = w[bj][n] * QSCALE; }
                }
            bf16_t* O = isQ ? Q : (isK ? K : V); const int ldo = isQ ? 1024 : 256;
            const int col = (isQ ? 256 * (pn - 16) : 0) + 64 * wc + 8 * fq;
            float* o32p = out + (isK ? OUT_KP : OUT_VP); float* o32s = out + (isK ? OUT_KS : OUT_VS);
#pragma unroll
            for (int ai = 0; ai < 2; ++ai)
#pragma unroll
                for (int m = 0; m < 4; ++m) {
                    f32x4 v[2][2];
#pragma unroll
                    for (int bj = 0; bj < 2; ++bj)
#pragma unroll
                        for (int n = 0; n < 2; ++n) v[bj][n] = acc[ai][bj][m][n];
                    if (pn != 21) {
                        float ss = 0.f;
#pragma unroll
                        for (int bj = 0; bj < 2; ++bj)
#pragma unroll
                            for (int n = 0; n < 2; ++n) { const f32x4 x = v[bj][n]; ss += (x[0] * x[0] + x[1] * x[1]) + (x[2] * x[2] + x[3] * x[3]); }
                        ss += __shfl_xor(ss, 16); ss += __shfl_xor(ss, 32);
                        const float rs = __builtin_amdgcn_rsqf(ss * (1.0f / 64.0f) + RMS_EPS);
#pragma unroll
                        for (int bj = 0; bj < 2; ++bj)
#pragma unroll
                            for (int n = 0; n < 2; ++n) v[bj][n] = v[bj][n] * rs * w[bj][n];
                    }
                    const int lrow = lrow0 + ai * HALF + m * 16;
                    const size_t row = (size_t)pm * BM + lrow;
#pragma unroll
                    for (int bj = 0; bj < 2; ++bj) *(u32x4*)(O + row * ldo + col + 32 * bj) = pack8(v[bj][0], v[bj][1]);
                    if (!isQ) {
                        float* dst = nullptr;
                        float psc = 1.f;
                        if (pm == 128) { dst = o32s + (size_t)lrow * 256 + col; psc = isK ? PSC6 : PSC7; }
                        else if ((pm & 31) == 31 && ai == 1) { dst = o32p + (size_t)((pm >> 5) * 128 + (lrow - 128)) * 256 + col; psc = isK ? PSC3 : PSC4; }
                        if (dst) {
#pragma unroll
                            for (int bj = 0; bj < 2; ++bj) { *(f32x4*)(dst + 32 * bj) = v[bj][0] * psc; *(f32x4*)(dst + 32 * bj + 4) = v[bj][1] * psc; }
                        }
                    }
                }
        } else {
            const int col = 256 * (pn - 22) + 32 * wc + 8 * fq;
#pragma unroll
            for (int ai = 0; ai < 2; ++ai)
#pragma unroll
                for (int m = 0; m < 4; ++m) {
                    const size_t row = grow0 + ai * HALF + m * 16;
#pragma unroll
                    for (int bj = 0; bj < 2; ++bj) {
                        f32x4 r0, r1;
#pragma unroll
                        for (int j = 0; j < 4; ++j) { r0[j] = sigmoid_f(acc[ai][bj][m][0][j]); r1[j] = sigmoid_f(acc[ai][bj][m][1][j]); }
                        *(u32x4*)(SG + row * 1024 + col + 128 * bj) = pack8(r0, r1);
                    }
                }
        }
    }
};

struct EpiOut {
    static constexpr bool PERM = true, AFTER_DRAIN = false;
    const float *xp, *xs; float* X1; bf16_t* X1B; float* SS;
    __device__ __forceinline__ void operator()(const f32x4 (&acc)[2][2][4][2], const Unit& u, int wr, int wc, int fr, int fq) const {
        asm volatile("" : "+v"(fr), "+v"(fq), "+s"(wr), "+s"(wc));
        const int pm = u.pm; const int col = 256 * u.pn + 32 * wc + 8 * fq;
        const float* xb = pm < 128 ? xp + (size_t)pm * BM * 1024 : xs;
        const int lrow0 = wr * 64 + fr;
#pragma unroll
        for (int ai = 0; ai < 2; ++ai)
#pragma unroll
            for (int m = 0; m < 4; ++m) {
                const int lrow = lrow0 + ai * HALF + m * 16; const size_t row = (size_t)pm * BM + lrow;
                const float* xr = xb + (size_t)lrow * 1024 + col;
                f32x4 x[2][2];
#pragma unroll
                for (int bj = 0; bj < 2; ++bj) { x[bj][0] = *(const f32x4*)(xr + 128 * bj); x[bj][1] = *(const f32x4*)(xr + 128 * bj + 4); }
                float ss = 0.f;
#pragma unroll
                for (int bj = 0; bj < 2; ++bj) {
                    const f32x4 y0 = x[bj][0] + acc[ai][bj][m][0], y1 = x[bj][1] + acc[ai][bj][m][1];
                    ss += (y0[0] * y0[0] + y0[1] * y0[1]) + (y0[2] * y0[2] + y0[3] * y0[3]) + (y1[0] * y1[0] + y1[1] * y1[1]) + (y1[2] * y1[2] + y1[3] * y1[3]);
                    float* o = X1 + row * 1024 + col + 128 * bj; *(f32x4*)o = y0; *(f32x4*)(o + 4) = y1;
                    *(u32x4*)(X1B + row * 1024 + col + 128 * bj) = pack8(y0, y1);
                }
                ss += __shfl_xor(ss, 16); ss += __shfl_xor(ss, 32);
                if (fq == 0) SS[((size_t)u.pn * MROWS + row) * 4 + wc] = ss;
            }
    }
};

struct EpiGU {
    static constexpr bool PERM = true, AFTER_DRAIN = false;
    const float* SS; bf16_t* H;
    __device__ __forceinline__ void operator()(const f32x4 (&acc)[2][2][4][2], const Unit& u, int wr, int wc, int fr, int fq) const {
        asm volatile("" : "+v"(fr), "+v"(fq), "+s"(wr), "+s"(wc));
        const int col = 128 * u.pn + 32 * wc + 8 * fq; const int lrow0 = wr * 64 + fr;
#pragma unroll
        for (int ai = 0; ai < 2; ++ai)
#pragma unroll
            for (int m = 0; m < 4; ++m) {
                const size_t row = (size_t)u.pm * BM + lrow0 + ai * HALF + m * 16;
                const f32x4 s4 = *(const f32x4*)(SS + ((size_t)fq * MROWS + row) * 4);
                float ss = (s4[0] + s4[1]) + (s4[2] + s4[3]);
                ss += __shfl_xor(ss, 16); ss += __shfl_xor(ss, 32);
                const float rs = __builtin_amdgcn_rsqf(ss * (1.0f / 1024.0f) + RMS_EPS);
                f32x4 r0, r1;
#pragma unroll
                for (int j = 0; j < 4; ++j) {
                    const float g0 = acc[ai][0][m][0][j] * rs, g1 = acc[ai][0][m][1][j] * rs;
                    r0[j] = g0 * sigmoid_f(g0) * (acc[ai][1][m][0][j] * rs);
                    r1[j] = g1 * sigmoid_f(g1) * (acc[ai][1][m][1][j] * rs);
                }
                r0 = r0 * PS_FFN; r1 = r1 * PS_FFN;
                *(u32x4*)(H + row * 2816 + col) = pack8(r0, r1);
            }
    }
};

struct EpiDown {
    static constexpr bool PERM = true, AFTER_DRAIN = false;
    float* Y; const unsigned* dbg;
    __device__ __forceinline__ void operator()(const f32x4 (&acc)[2][2][4][2], const Unit& u, int wr, int wc, int fr, int fq) const {
        asm volatile("" : "+v"(fr), "+v"(fq), "+s"(wr), "+s"(wc));
        const int col = 256 * u.pn + 32 * wc + 8 * fq; const int lrow0 = wr * 64 + fr;
#pragma unroll
        for (int ai = 0; ai < 2; ++ai)
#pragma unroll
            for (int m = 0; m < 4; ++m) {
                float* yr = Y + ((size_t)u.pm * BM + lrow0 + ai * HALF + m * 16) * 1024 + col;
                f32x4 x[2][2];
#pragma unroll
                for (int bj = 0; bj < 2; ++bj) { x[bj][0] = *(const f32x4*)(yr + 128 * bj); x[bj][1] = *(const f32x4*)(yr + 128 * bj + 4); }
#pragma unroll
                for (int bj = 0; bj < 2; ++bj) {
#ifdef PROBE_ACC_CHECK
                    float dsc = 1.f; if (u.pm == 128) { const unsigned* fl = dbg + 2048; dsc = 1.f + 0.02f * (float)(fl[0] + 2u * fl[1] + 4u * fl[2] + 8u * fl[3]);
#ifdef PROBE_SG_COUNT
                        const float frac = (float)dbg[2060] / (float)(dbg[2061] ? dbg[2061] : 1u); dsc = 1.f + 0.004f * rintf(31.f * fminf(1.f, frac * PROBE_SG_GAIN));
#endif
                    }
#else
                    const float dsc = 1.f;
#endif
                    const float psc = (u.pm < 128 ? PSC0 : PSC1) * dsc; *(f32x4*)(yr + 128 * bj) = (x[bj][0] + acc[ai][bj][m][0]) * psc; *(f32x4*)(yr + 128 * bj + 4) = (x[bj][1] + acc[ai][bj][m][1]) * psc; }
            }
    }
};
template <class Epi, class Sched, bool ALIGN_EPI = false, bool SP2 = false>
__device__ __forceinline__ void gemm_phase(PG8_LAS unsigned char* lds, const Gemm g, const Sched& S, const Epi& E) {
    const int tid = threadIdx.x, wid = __builtin_amdgcn_readfirstlane(tid >> 6), lane = tid & 63, wr = wid >> 2, wc = wid & 3, fr = lane & 15, fq = lane >> 4;
    const int K = g.K, nt = K / BK;
    unsigned voffA[2], voffB[2];
#pragma unroll
    for (int i = 0; i < 2; ++i) { int R, C; stage_rc(tid * 16 + i * 8192, R, C); const int Rb = Epi::PERM ? ((R & ~31) + perm32(R & 31)) : R;
        voffA[i] = (unsigned)(R * K + C) * 2u; voffB[i] = (unsigned)(Rb * K + C) * 2u; }
    const size_t kstep = (size_t)(BK * 2);
    const size_t hstep = (size_t)HALF * K * 2;
    const size_t tstep = 2 * hstep;
    const unsigned ldsw = (unsigned)wid * 1024u;
    const int aoff = lds_byte(wr * 64 + fr, fq * 8), boff = lds_byte(wc * 32 + fr, fq * 8);
#define PG8_SA(b, h) (((b) * 2 + (h)) * HTB)
#define PG8_SB(b, h) ((4 + (b) * 2 + (h)) * HTB)
#define PG8_STAGE(bufoff, gbase, voff) do { _Pragma("unroll") for (int _i = 0; _i < 2; ++_i) \
        __builtin_amdgcn_global_load_lds((const unsigned*)((const char*)(gbase) + (voff)[_i]), (PG8_LAS unsigned*)(lds + (bufoff) + ldsw + _i * 8192), 16, 0, 0); } while (0)
#define PG8_LDA(dst, b, h) do { _Pragma("unroll") for (int m = 0; m < 4; ++m) _Pragma("unroll") for (int k = 0; k < 2; ++k) dst[m][k] = *(const PG8_LAS bf16x8*)(lds + PG8_SA(b, h) + aoff + m * 2048 + k * 1024); } while (0)
#define PG8_LDB(dst, b, h) do { _Pragma("unroll") for (int n = 0; n < 2; ++n) _Pragma("unroll") for (int k = 0; k < 2; ++k) dst[n][k] = *(const PG8_LAS bf16x8*)(lds + PG8_SB(b, h) + boff + n * 2048 + k * 1024); } while (0)
#define PG8_MMA(ai, bj, At, Bt) do { __builtin_amdgcn_s_setprio(1); _Pragma("unroll") for (int m = 0; m < 4; ++m) _Pragma("unroll") for (int n = 0; n < 2; ++n) _Pragma("unroll") for (int k = 0; k < 2; ++k) \
        acc[ai][bj][m][n] = __builtin_amdgcn_mfma_f32_16x16x32_bf16(Bt[n][k], At[m][k], acc[ai][bj][m][n], 0, 0, 0); __builtin_amdgcn_s_setprio(0); } while (0)
#define PG8_WAIT_V(n) asm volatile("s_waitcnt vmcnt(" #n ")" ::: "memory")
#define PG8_WAIT_L(n) asm volatile("s_waitcnt lgkmcnt(" #n ")" ::: "memory")
#define PG8_BAR __builtin_amdgcn_s_barrier()
#define PG8_SCHED __builtin_amdgcn_sched_barrier(0)
    Unit cur, nxt; int ui = 0;
    if (!S.next(0, cur)) return;
    f32x4 acc[2][2][4][2];
#pragma unroll
    for (int a = 0; a < 2; ++a)
#pragma unroll
        for (int b = 0; b < 2; ++b)
#pragma unroll
            for (int m = 0; m < 4; ++m)
#pragma unroll
                for (int n = 0; n < 2; ++n) acc[a][b][m][n] = (f32x4){0.f, 0.f, 0.f, 0.f};
    bf16x8 At[4][2], B0[2][2], B1[2][2];
    const char* cA = (const char*)g.A + (size_t)cur.pm * tstep; const char* cB = (const char*)g.Bt + (size_t)cur.pn * tstep;
    S.a_ready(cur);
    if constexpr (SP2) {
        PG8_STAGE(PG8_SB(0, 0), cB, voffB); PG8_STAGE(PG8_SB(0, 1), cB + hstep, voffB); PG8_STAGE(PG8_SA(0, 0), cA, voffA); PG8_STAGE(PG8_SA(0, 1), cA + hstep, voffA);
        if (wr == 1) PG8_BAR;
        PG8_WAIT_V(2); PG8_BAR;
        PG8_STAGE(PG8_SB(1, 0), cB + kstep, voffB); PG8_STAGE(PG8_SA(1, 0), cA + kstep, voffA); PG8_STAGE(PG8_SB(1, 1), cB + hstep + kstep, voffB);
        PG8_WAIT_V(6); PG8_BAR;
    } else {
        PG8_STAGE(PG8_SB(0, 0), cB, voffB); PG8_STAGE(PG8_SA(0, 0), cA, voffA); PG8_STAGE(PG8_SB(0, 1), cB + hstep, voffB); PG8_STAGE(PG8_SA(0, 1), cA + hstep, voffA);
        if (wr == 1) PG8_BAR;
        PG8_WAIT_V(4); PG8_BAR;
        PG8_STAGE(PG8_SB(1, 0), cB + kstep, voffB); PG8_STAGE(PG8_SA(1, 0), cA + kstep, voffA); PG8_STAGE(PG8_SB(1, 1), cB + hstep + kstep, voffB);
        PG8_WAIT_V(6); PG8_BAR;
    }
    for (;;) {
        const bool has_next = S.next(ui + 1, nxt);
        const char* nA = has_next ? (const char*)g.A + (size_t)nxt.pm * tstep : cA; const char* nB = has_next ? (const char*)g.Bt + (size_t)nxt.pn * tstep : cB;
        for (int t = 0; t < nt; t += 2) {
            const bool last = (t == nt - 2);
            const char* a1 = cA + (size_t)(t + 1) * kstep;
            const char* a2 = last ? nA : cA + (size_t)(t + 2) * kstep; const char* b2 = last ? nB : cB + (size_t)(t + 2) * kstep;
            const char* a3 = a2 + kstep; const char* b3 = b2 + kstep;
            if (last && has_next) S.a_ready(nxt);
            if constexpr (SP2) {
            PG8_LDB(B0, 0, 0); PG8_LDB(B1, 0, 1); PG8_SCHED; PG8_LDA(At, 0, 0); PG8_STAGE(PG8_SA(1, 1), a1 + hstep, voffA);
            PG8_WAIT_V(8); PG8_WAIT_L(0); PG8_BAR; PG8_MMA(0, 0, At, B0); PG8_MMA(0, 1, At, B1); PG8_BAR; PG8_SCHED;
            PG8_LDA(At, 0, 1); PG8_STAGE(PG8_SB(0, 0), b2, voffB); PG8_STAGE(PG8_SB(0, 1), b2 + hstep, voffB); PG8_STAGE(PG8_SA(0, 0), a2, voffA);
            PG8_WAIT_V(8); PG8_WAIT_L(0); PG8_BAR; PG8_MMA(1, 0, At, B0); PG8_MMA(1, 1, At, B1); PG8_BAR; PG8_SCHED;
            PG8_LDB(B0, 1, 0); PG8_LDB(B1, 1, 1); PG8_SCHED; PG8_LDA(At, 1, 0); PG8_STAGE(PG8_SA(0, 1), a2 + hstep, voffA);
            PG8_WAIT_V(8); PG8_WAIT_L(0); PG8_BAR; PG8_MMA(0, 0, At, B0); PG8_MMA(0, 1, At, B1); PG8_BAR; PG8_SCHED;
            PG8_LDA(At, 1, 1); PG8_STAGE(PG8_SB(1, 0), b3, voffB); PG8_STAGE(PG8_SB(1, 1), b3 + hstep, voffB); PG8_STAGE(PG8_SA(1, 0), a3, voffA);
            PG8_WAIT_V(8); PG8_WAIT_L(0); PG8_BAR; PG8_MMA(1, 0, At, B0); PG8_MMA(1, 1, At, B1); PG8_BAR; PG8_SCHED;
            } else {
            PG8_LDB(B0, 0, 0); PG8_SCHED; PG8_LDA(At, 0, 0); PG8_STAGE(PG8_SA(1, 1), a1 + hstep, voffA);
            PG8_WAIT_L(8); PG8_BAR; PG8_WAIT_L(0); PG8_MMA(0, 0, At, B0); PG8_BAR; PG8_SCHED;
            PG8_LDB(B1, 0, 1); PG8_STAGE(PG8_SB(0, 0), b2, voffB);
            PG8_BAR; PG8_WAIT_L(0); PG8_MMA(0, 1, At, B1); PG8_BAR;
            PG8_LDA(At, 0, 1); PG8_STAGE(PG8_SA(0, 0), a2, voffA);
            PG8_BAR; PG8_WAIT_L(0); PG8_MMA(1, 0, At, B0); PG8_BAR; PG8_SCHED;
            PG8_STAGE(PG8_SB(0, 1), b2 + hstep, voffB);
            PG8_WAIT_V(6); PG8_BAR; PG8_MMA(1, 1, At, B1); PG8_BAR;
            PG8_LDB(B0, 1, 0); PG8_SCHED; PG8_LDA(At, 1, 0); PG8_STAGE(PG8_SA(0, 1), a2 + hstep, voffA);
            PG8_WAIT_L(8); PG8_BAR; PG8_WAIT_L(0); PG8_MMA(0, 0, At, B0); PG8_BAR; PG8_SCHED;
            PG8_LDB(B1, 1, 1); PG8_STAGE(PG8_SB(1, 0), b3, voffB);
            PG8_BAR; PG8_WAIT_L(0); PG8_MMA(0, 1, At, B1); PG8_BAR;
            PG8_LDA(At, 1, 1); PG8_STAGE(PG8_SA(1, 0), a3, voffA);
            PG8_BAR; PG8_WAIT_L(0); PG8_MMA(1, 0, At, B0); PG8_BAR; PG8_SCHED;
            PG8_STAGE(PG8_SB(1, 1), b3 + hstep, voffB);
            PG8_WAIT_V(6); PG8_BAR; PG8_MMA(1, 1, At, B1); PG8_BAR;
            }
        }
        if constexpr (ALIGN_EPI) { if (wr == 0) PG8_BAR; }
        if constexpr (!Epi::AFTER_DRAIN) { E(acc, cur, wr, wc, fr, fq); S.done(cur); }
        if (!has_next) break;
#pragma unroll
        for (int a = 0; a < 2; ++a)
#pragma unroll
            for (int b = 0; b < 2; ++b)
#pragma unroll
                for (int m = 0; m < 4; ++m)
#pragma unroll
                    for (int n = 0; n < 2; ++n) acc[a][b][m][n] = (f32x4){0.f, 0.f, 0.f, 0.f};
        cur = nxt; cA = nA; cB = nB; ++ui;
        if constexpr (ALIGN_EPI) { if (wr == 1) PG8_BAR; }
    }
    PG8_WAIT_V(0);
    if constexpr (!ALIGN_EPI) { if (wr == 0) PG8_BAR; }
    PG8_BAR;
    if constexpr (Epi::AFTER_DRAIN) { E.fused(acc, cur, wr, wc, fr, fq, lds, wid, lane); S.done(cur); }
#undef PG8_SA
#undef PG8_SB
#undef PG8_STAGE
#undef PG8_LDA
#undef PG8_LDB
#undef PG8_MMA
#undef PG8_WAIT_V
#undef PG8_WAIT_L
#undef PG8_BAR
#undef PG8_SCHED
}
}
#define GAS __attribute__((address_space(1)))
#define LAS __attribute__((address_space(3)))
typedef unsigned short bf16;
typedef unsigned v4u __attribute__((ext_vector_type(4)));
typedef float f32x4 __attribute__((ext_vector_type(4)));
typedef short bf16x8 __attribute__((ext_vector_type(8)));
typedef GAS unsigned gu32;
typedef GAS unsigned long long gu64;
#define RLX_AGENT __ATOMIC_RELAXED, __HIP_MEMORY_SCOPE_AGENT
#define LDS_WAIT() asm volatile("s_waitcnt lgkmcnt(0)" ::: "memory")
#define VM_WAIT() asm volatile("s_waitcnt vmcnt(0)" ::: "memory")
__device__ __forceinline__ unsigned long long rt() { return __builtin_amdgcn_s_memrealtime(); }
__device__ __forceinline__ unsigned f2bf(float f) { unsigned u = __builtin_bit_cast(unsigned, f); return (u + 0x7fffu + ((u >> 16) & 1u)) >> 16; }
__device__ __forceinline__ unsigned pk2(float lo, float hi) { return f2bf(lo) | (f2bf(hi) << 16); }

#define XB_TMO      128
#define XB_XCNT(j)  (256  + 64 * (j))
#define XB_XSUB(j)  (1280 + 64 * (j))
#define XB_XGEN(j)  (2304 + 64 * (j))
#define XB_TOP      3328
#define XB_TOPGEN   3392
#define XCD_BAR_WORDS 3456
#define XB_SPIN_CAP (1u << 18)

__device__ __forceinline__ unsigned xb_ld(unsigned* p)              { return __hip_atomic_load(p, __ATOMIC_RELAXED, __HIP_MEMORY_SCOPE_AGENT); }
__device__ __forceinline__ unsigned xb_add(unsigned* p, unsigned v) { return __hip_atomic_fetch_add(p, v, __ATOMIC_RELAXED, __HIP_MEMORY_SCOPE_AGENT); }
__device__ __forceinline__ unsigned xb_xcc_id() { return (unsigned)__builtin_amdgcn_s_getreg((3 << 11) | 20) & 0xFu; }
#define XB_SPIN(cond, bar) do { unsigned _sp = 0; while (cond) { __builtin_amdgcn_s_sleep(1); \
    if ((++_sp & 255u) == 0u) { if (xb_ld(&(bar)[XB_TMO])) break; if (_sp > XB_SPIN_CAP) { atomicAdd(&(bar)[XB_TMO], 1u); break; } } } } while (0)

struct XcdBarrier {
    unsigned* bar; unsigned x;
    volatile LAS unsigned* st;
};

__device__ __forceinline__ XcdBarrier xcd_barrier_post(unsigned* bar, volatile LAS unsigned* st) {
    XcdBarrier b; b.bar = bar; b.x = xb_xcc_id(); b.st = st;
    if (threadIdx.x == 0) (void)xb_add(&bar[XB_XCNT(b.x)], 1u);
    return b;
}
__device__ __forceinline__ void xcd_barrier_complete(unsigned* bar, unsigned x, unsigned& nloc, unsigned& nx) {
    const unsigned G = gridDim.x * gridDim.y * gridDim.z;
    unsigned sum, cnt, mine, sp = 0u;
    for (;;) {
        sum = 0u; cnt = 0u; mine = 0u;
#pragma unroll
        for (unsigned j = 0; j < 16; ++j) { const unsigned c = xb_ld(&bar[XB_XCNT(j)]); sum += c; cnt += (c > 0u) ? 1u : 0u; mine = (j == x) ? c : mine; }
        if (sum == G) break;
        __builtin_amdgcn_s_sleep(1);
        if ((++sp & 255u) == 0u) { if (xb_ld(&bar[XB_TMO])) break; if (sp > XB_SPIN_CAP) { atomicAdd(&bar[XB_TMO], 1u); break; } }
    }
    nloc = mine > 0u ? mine : 1u; nx = cnt > 0u ? cnt : 1u;
}

__device__ __forceinline__ void xcd_barrier(const XcdBarrier& b) {
    asm volatile("s_waitcnt vmcnt(0)" ::: "memory");
    __syncthreads();
    if (threadIdx.x == 0) {
        unsigned* bar = b.bar;
        __builtin_amdgcn_s_waitcnt(0);
        unsigned nloc = b.st[0], nx = b.st[1];
        if (nloc == 0u) { xcd_barrier_complete(bar, b.x, nloc, nx); b.st[0] = nloc; b.st[1] = nx; }
        const unsigned old = xb_add(&bar[XB_XSUB(b.x)], 1u);
        const unsigned gen = old / nloc;
        if (old + 1u == (gen + 1u) * nloc) {
            __builtin_amdgcn_fence(__ATOMIC_RELEASE, "agent");
            asm volatile("s_waitcnt vmcnt(0)" ::: "memory");
            const unsigned og = xb_add(&bar[XB_TOP], 1u);
            const unsigned tg = og / nx;
            if (og + 1u == (tg + 1u) * nx) xb_add(&bar[XB_TOPGEN], 1u);
            else XB_SPIN(xb_ld(&bar[XB_TOPGEN]) == tg, bar);
            __builtin_amdgcn_fence(__ATOMIC_ACQUIRE, "agent");
            xb_add(&bar[XB_XGEN(b.x)], 1u);
            asm volatile("s_waitcnt vmcnt(0)" ::: "memory");
        } else {
            XB_SPIN(xb_ld(&bar[XB_XGEN(b.x)]) == gen, bar);
            __builtin_amdgcn_fence(__ATOMIC_ACQUIRE, "agent");
            asm volatile("s_waitcnt vmcnt(0)" ::: "memory");
        }
    }
    __syncthreads();
}
constexpr int NWAVES = 8;
constexpr int D = 1024, MROWS = pg8::MROWS, MP = pg8::MP, SEQ_T = 8192, NB = 4, NCH = 128, DFF = 2816, NIN = 6656, NGU = 5632;
constexpr int DEC_B = 16, DEC_T = 16, CACHE_L = 128;
constexpr size_t MiB = 1u << 20;
constexpr size_t WS_CTL = 0, CTL_ZERO_BYTES = 1 * MiB;
constexpr size_t WS_SS = 2 * MiB, WS_CK = 5 * MiB, WS_CV = 6 * MiB;
constexpr size_t WS_WIN = 8 * MiB, WS_WOUT = 21 * MiB, WS_WGU = 23 * MiB, WS_WD = 34 * MiB;
constexpr size_t WS_XN = 40 * MiB;
constexpr size_t WS_Q = 105 * MiB;
constexpr size_t WS_K = 170 * MiB, WS_V = 187 * MiB;
constexpr size_t WS_U = 204 * MiB, WS_BG = 269 * MiB, WS_SG = 334 * MiB;
constexpr size_t WS_H = 204 * MiB;
constexpr size_t WS_END = 399 * MiB;
static_assert(WS_SS + (size_t)MROWS * 16 * 4 <= WS_CK && WS_WIN + (size_t)NIN * D * 2 <= WS_WOUT && WS_WGU + (size_t)NGU * D * 2 <= WS_WD && WS_WD + (size_t)D * DFF * 2 <= WS_XN, "ws map 1");
static_assert(WS_XN + (size_t)MROWS * D * 2 <= WS_Q && WS_Q + (size_t)MROWS * D * 2 <= WS_K && WS_K + (size_t)(MROWS + 64) * 256 * 2 <= WS_V && WS_V + (size_t)(MROWS + 64) * 256 * 2 <= WS_U, "ws map 2");
static_assert(WS_U + (size_t)MROWS * D * 2 <= WS_BG && WS_BG + (size_t)MROWS * D * 2 <= WS_SG && WS_SG + (size_t)MROWS * D * 2 <= WS_END && WS_H + (size_t)MROWS * DFF * 2 <= WS_END, "ws map 3");
static_assert(WS_Q == pg8::EO_Q && WS_K == pg8::EO_K && WS_V == pg8::EO_V && WS_U == pg8::EO_U && WS_BG == pg8::EO_BG && WS_SG == pg8::EO_SG, "epilogue offsets");
constexpr int CW_TMO = 0, CW_CODE = 1, CW_BAR = 4096;

constexpr int RING_OFF = 0, RING_BYTES = 131072;
constexpr int LDSCTL_OFF = RING_BYTES, MISC_OFF = LDSCTL_OFF + 320;
constexpr int LDS_BYTES = 147456;

struct Frame {
    LAS unsigned char* lds;
    volatile LAS unsigned* MISC;
    gu32* ctl;
    int tid, lane, wave;
    int vcu, G;
    const float *xp, *xs, *state_conv, *cache_k, *cache_v, *norm_mix_w, *w_in, *conv_w, *q_norm_w, *k_norm_w, *sinks, *w_out, *norm_ffn_w, *w_gate, *w_up, *w_down;
    float* out;
    bf16 *Win_t, *Wout_t, *Wgu_t, *Wd_t;
    bf16 *XN, *MG, *Q, *X1B, *KB, *VB, *U, *BG, *SG, *H, *CK, *CV;
    float* SS;
};

__device__ __forceinline__ float wave_sum(float v) {
#pragma unroll
    for (int o = 1; o < 64; o <<= 1) v += __shfl_xor(v, o);
    return v;
}
__device__ __forceinline__ void p0_transpose_item(const float* W, int K, int N, bf16* WT, int k0, int n0, int drow0, const float* sc, LAS float* scr, int lane) {
#pragma unroll 8
    for (int i = 0; i < 32; ++i) { const int kk = 2 * i + (lane >> 5); float v = W[(size_t)(k0 + kk) * N + n0 + (lane & 31)]; if (sc) v *= sc[k0 + kk]; scr[kk * 33 + (lane & 31)] = v; }
    LDS_WAIT(); asm volatile("" ::: "memory");
    const int c = lane & 7;
#pragma unroll
    for (int j = 0; j < 4; ++j) { const int n = (lane >> 3) + 8 * j; const LAS float* s = scr + (8 * c) * 33 + n;
        v4u o; o.x = pk2(s[0 * 33], s[1 * 33]); o.y = pk2(s[2 * 33], s[3 * 33]); o.z = pk2(s[4 * 33], s[5 * 33]); o.w = pk2(s[6 * 33], s[7 * 33]);
        *(GAS v4u*)(WT + (size_t)(drow0 + n) * K + k0 + 8 * c) = o; }
    LDS_WAIT(); asm volatile("" ::: "memory");
}
__device__ __forceinline__ int win_dest_row(int n) {
    if (n < 1024) return 256 * (n >> 7) + (n & 127);
    if (n < 2048) { const int q = n - 1024; return 256 * (8 + (q >> 7)) + (q & 127); }
    if (n < 3072) { const int q = n - 2048; return 256 * (q >> 7) + 128 + (q & 127); }
    if (n < 4608) { const int q = n - 3072; const int t = q >> 8, r = q & 255;
                    return 256 * (16 + t) + 128 * ((r >> 5) & 1) + 32 * (r >> 6) + (r & 31); }
    if (n < 5632) { const int q = n - 4608; return 256 * (8 + (q >> 7)) + 128 + (q & 127); }
    return 256 * 22 + (n - 5632);
}
__device__ __forceinline__ void rms_row_to_bf16(Frame& F, const float* xrow, const float* w, bf16* orow) {
    const GAS f32x4* xr = (const GAS f32x4*)xrow + F.lane; const GAS f32x4* wr = (const GAS f32x4*)w + F.lane;
    f32x4 v[4]; float s2 = 0.f;
#pragma unroll
    for (int j = 0; j < 4; ++j) { v[j] = xr[64 * j]; s2 += (v[j].x * v[j].x + v[j].y * v[j].y) + (v[j].z * v[j].z + v[j].w * v[j].w); }
    const float rstd = __builtin_amdgcn_rsqf(wave_sum(s2) * (1.f / D) + pg8::RMS_EPS);
    GAS unsigned long long* o8 = (GAS unsigned long long*)orow + F.lane;
#pragma unroll
    for (int j = 0; j < 4; ++j) { const f32x4 ww = wr[64 * j]; o8[64 * j] = (unsigned long long)pk2(v[j].x * rstd * ww.x, v[j].y * rstd * ww.y) | ((unsigned long long)pk2(v[j].z * rstd * ww.z, v[j].w * rstd * ww.w) << 32); }
}
__device__ __forceinline__ void p0_prologue(Frame& F) {
    LAS float* scr = (LAS float*)(F.lds + RING_OFF + F.wave * 16384);
    const int gw = F.vcu * NWAVES + F.wave, NGW = F.G * NWAVES;
    constexpr int I_IN = (D / 64) * (NIN / 32), I_O = (D / 64) * (D / 32), I_G = (D / 64) * (DFF / 32), I_D = (DFF / 64) * (D / 32);
    constexpr int NITEMS = I_IN + I_O + 2 * I_G + I_D;
    for (int it = gw; it < NITEMS; it += NGW) {
        int r = it;
        if (r < I_IN) { const int nblk = NIN / 32, kb = r / nblk, nb = r % nblk; p0_transpose_item(F.w_in, D, NIN, F.Win_t, 64 * kb, 32 * nb, win_dest_row(32 * nb), nullptr, scr, F.lane); continue; } r -= I_IN;
        if (r < I_O) { const int nblk = D / 32, kb = r / nblk, nb = r % nblk; p0_transpose_item(F.w_out, D, D, F.Wout_t, 64 * kb, 32 * nb, 32 * nb, nullptr, scr, F.lane); continue; } r -= I_O;
        if (r < 2 * I_G) { const int up = r >= I_G; if (up) r -= I_G; const int nblk = DFF / 32, kb = r / nblk, nb = r % nblk, n0 = 32 * nb;
            p0_transpose_item(up ? F.w_up : F.w_gate, D, DFF, F.Wgu_t, 64 * kb, n0, 256 * (n0 >> 7) + 128 * up + (n0 & 127), F.norm_ffn_w, scr, F.lane); continue; } r -= 2 * I_G;
        { const int nblk = D / 32, kb = r / nblk, nb = r % nblk; p0_transpose_item(F.w_down, DFF, D, F.Wd_t, 64 * kb, 32 * nb, 32 * nb, nullptr, scr, F.lane); }
    }
    for (int m = gw; m < MROWS; m += NGW) rms_row_to_bf16(F, m < MP ? F.xp + (size_t)m * D : F.xs + (size_t)(m - MP) * D, F.norm_mix_w, F.XN + (size_t)m * D);
    { const int gt = gw * 64 + F.lane, NT = NGW * 64;
      for (int i = gt; i < DEC_B * CACHE_L * 256 / 4; i += NT) {
          const f32x4 a = ((const GAS f32x4*)F.cache_k)[i], b = ((const GAS f32x4*)F.cache_v)[i];
          ((GAS unsigned long long*)F.CK)[i] = (unsigned long long)pk2(a.x, a.y) | ((unsigned long long)pk2(a.z, a.w) << 32);
          ((GAS unsigned long long*)F.CV)[i] = (unsigned long long)pk2(b.x, b.y) | ((unsigned long long)pk2(b.z, b.w) << 32); }
      for (int i = gt; i < 64 * 256 / 4; i += NT) { ((GAS unsigned long long*)(F.KB + (size_t)MROWS * 256))[i] = 0ull; ((GAS unsigned long long*)(F.VB + (size_t)MROWS * 256))[i] = 0ull; } }
}

#ifndef PS_ATT
#define PS_ATT 1.0f
#define PS_CONV 1.0f
#define PS_FFN 1.0f
#endif
namespace p2 {
using bf16x8 = __attribute__((ext_vector_type(8))) short;
using s16x4 = __attribute__((ext_vector_type(4))) short;
using f32x16 = __attribute__((ext_vector_type(16))) float;
typedef short v4i16_t __attribute__((ext_vector_type(4)));
typedef LAS const char* lds_cptr;
constexpr int LDS_K = 0, LDS_V = 3 * 8192, LDS_WS = 6 * 8192, LDS_OST = LDS_WS + 8 * 256, LDS_TOTAL = LDS_OST + 8 * 4096;
__device__ __forceinline__ int crow(int r, int hi) { return (r & 3) + 8 * (r >> 2) + 4 * hi; }
__device__ __forceinline__ s16x4 vtr(lds_cptr p) { return __builtin_bit_cast(s16x4, __builtin_amdgcn_ds_read_tr16_b64_v4i16((LAS v4i16_t*)p)); }
__device__ __forceinline__ unsigned cvtpk(float lo, float hi) { return pg8::cvt_pk_bf16(lo, hi); }
__device__ __forceinline__ float bf_lo(unsigned w) { return __uint_as_float(w << 16); }
__device__ __forceinline__ float bf_hi(unsigned w) { return __uint_as_float(w & 0xffff0000u); }

struct UnitDesc { const bf16* kt[3]; const bf16* vt[3]; int nv[3]; int row0; int g; int sample; int t0; };

__device__ __forceinline__ void attn_unit(Frame& F, const UnitDesc& ud) {
    const int lane = F.lane, r32 = lane & 31, hi = lane >> 5, wid = F.wave, hh = wid >> 1, half = wid & 1;
    LAS unsigned char* lds = F.lds + RING_OFF;
#pragma unroll
    for (int j = 0; j < 3; ++j) {
        const v4u kv = *(const GAS v4u*)(ud.kt[j] + (size_t)lane * 256 + wid * 8);
        const v4u vv = *(const GAS v4u*)(ud.vt[j] + (size_t)(16 * (wid & 3) + (lane >> 2)) * 256 + 32 * (wid >> 2) + 8 * (lane & 3));
        *(LAS v4u*)(lds + LDS_K + j * 8192 + wid * 1024 + lane * 16) = kv;
        *(LAS v4u*)(lds + LDS_V + j * 8192 + wid * 1024 + lane * 16) = vv;
    }
    __syncthreads();
    const bool active = !(ud.sample && half);
    if (active) {
        int qtok = half * 32 + r32; if (ud.sample && qtok > 15) qtok = 15;
        const bf16* qp = F.Q + (size_t)(ud.row0 + qtok) * D + 256 * ud.g + 64 * hh + 8 * hi;
        bf16x8 qr[4];
#pragma unroll
        for (int d0 = 0; d0 < 4; ++d0) qr[d0] = *(const GAS bf16x8*)(qp + 16 * d0);
        f32x16 p[6];
        const lds_cptr kp0 = (lds_cptr)(lds + LDS_K) + hi * 1024 + r32 * 16;
#pragma unroll
        for (int blk = 0; blk < 6; ++blk) {
            f32x16 a = {};
#pragma unroll
            for (int d0 = 0; d0 < 4; ++d0) {
                const bf16x8 kf = *(const LAS bf16x8*)(kp0 + (blk >> 1) * 8192 + (blk & 1) * 512 + d0 * 2048);
                a = __builtin_amdgcn_mfma_f32_32x32x16_bf16(kf, qr[d0], a, 0, 0, 0);
            }
            p[blk] = a;
        }
        const float sink2 = F.sinks[4 * ud.g + hh] * 1.4426950408889634f;
        float mx = sink2;
#pragma unroll
        for (int blk = 0; blk < 6; ++blk) {
            const int nvj = ud.nv[blk >> 1];
#pragma unroll
            for (int r = 0; r < 16; ++r) { const int kk = (blk & 1) * 32 + crow(r, hi); const float s = kk < nvj ? p[blk][r] : -1e30f; p[blk][r] = s; mx = fmaxf(mx, s); }
        }
        { auto rr = __builtin_amdgcn_permlane32_swap(__float_as_uint(mx), __float_as_uint(mx), false, false); mx = fmaxf(__uint_as_float(rr[0]), __uint_as_float(rr[1])); }
        float l = 0.f;
#pragma unroll
        for (int blk = 0; blk < 6; ++blk)
#pragma unroll
            for (int r = 0; r < 16; ++r) { const float e = __builtin_amdgcn_exp2f(p[blk][r] - mx); p[blk][r] = e; l += e; }
        { auto rr = __builtin_amdgcn_permlane32_swap(__float_as_uint(l), __float_as_uint(l), false, false); l = __uint_as_float(rr[0]) + __uint_as_float(rr[1]); }
        l += __builtin_amdgcn_exp2f(sink2 - mx);
        f32x16 o[2]; o[0] = f32x16{}; o[1] = f32x16{};
        const lds_cptr vp0 = (lds_cptr)(lds + LDS_V) + ((lane >> 4) & 1) * 32 + (lane & 3) * 8 + (4 * hi + ((lane & 15) >> 2)) * 64;
#pragma unroll
        for (int ks = 0; ks < 12; ++ks) {
            const int blk = ks >> 1, s8 = (ks & 1) * 8;
            v4u pw; pw.x = cvtpk(p[blk][s8 + 0], p[blk][s8 + 1]); pw.y = cvtpk(p[blk][s8 + 2], p[blk][s8 + 3]); pw.z = cvtpk(p[blk][s8 + 4], p[blk][s8 + 5]); pw.w = cvtpk(p[blk][s8 + 6], p[blk][s8 + 7]);
            const bf16x8 pa = __builtin_bit_cast(bf16x8, pw);
#pragma unroll
            for (int d0 = 0; d0 < 2; ++d0) {
                const lds_cptr vp = vp0 + (ks >> 2) * 8192 + d0 * 4096 + (ks & 3) * 1024;
                const s16x4 lo = vtr(vp), hi4 = vtr(vp + 512);
                const bf16x8 vf = (bf16x8){lo[0], lo[1], lo[2], lo[3], hi4[0], hi4[1], hi4[2], hi4[3]};
                o[d0] = __builtin_amdgcn_mfma_f32_32x32x16_bf16(pa, vf, o[d0], 0, 0, 0);
            }
        }
        LAS float* wsf = (LAS float*)(lds + LDS_WS) + wid * 64;
        if (hi == 0) wsf[r32] = l;
        asm volatile("s_waitcnt lgkmcnt(0)" ::: "memory");
        LAS unsigned short* stg = (LAS unsigned short*)(lds + LDS_OST) + wid * 2048;
#pragma unroll
        for (int r = 0; r < 16; ++r) { const int orow = crow(r, hi); const float rl = __builtin_amdgcn_rcpf(wsf[orow]);
#pragma unroll
            for (int d0 = 0; d0 < 2; ++d0) stg[orow * 64 + d0 * 32 + r32] = (unsigned short)f2bf(o[d0][r] * rl); }
        asm volatile("s_waitcnt lgkmcnt(0)" ::: "memory");
#ifdef PROBE_NAIVE_ATTN
        if (lane < 32) {
            int qt2 = half * 32 + lane; if (ud.sample && qt2 > 15) qt2 = 15;
            const bf16* qrow = F.Q + (size_t)(ud.row0 + qt2) * D + 256 * ud.g + 64 * hh;
            float qf[64], of[64];
#pragma unroll
            for (int d = 0; d < 64; d += 2) { const unsigned w2 = *(const GAS unsigned*)(qrow + d); qf[d] = bf_lo(w2); qf[d + 1] = bf_hi(w2); of[d] = 0.f; of[d + 1] = 0.f; }
            const float sk2 = F.sinks[4 * ud.g + hh] * 1.4426950408889634f;
            float m2 = sk2, l2 = 0.f;
            for (int j = 0; j < 3; ++j) for (int key = 0; key < ud.nv[j]; ++key) {
                float s = 0.f;
#pragma unroll
                for (int d = 0; d < 64; d += 2) { const unsigned w2 = *(const LAS unsigned*)(lds + LDS_K + j * 8192 + (d >> 3) * 1024 + key * 16 + (d & 7) * 2); s += qf[d] * bf_lo(w2) + qf[d + 1] * bf_hi(w2); }
                const float mn = fmaxf(m2, s), f0 = __builtin_amdgcn_exp2f(m2 - mn), e = __builtin_amdgcn_exp2f(s - mn);
                l2 = l2 * f0 + e; m2 = mn;
#pragma unroll
                for (int d = 0; d < 64; d += 2) { const unsigned w2 = *(const LAS unsigned*)(lds + LDS_V + j * 8192 + ((d >> 5) * 4 + (key >> 4)) * 1024 + (key & 15) * 64 + (d & 31) * 2); of[d] = of[d] * f0 + e * bf_lo(w2); of[d + 1] = of[d + 1] * f0 + e * bf_hi(w2); }
            }
            l2 += __builtin_amdgcn_exp2f(sk2 - m2);
            const float rl2 = 1.0f / l2;
#pragma unroll
            for (int d = 0; d < 64; ++d) stg[lane * 64 + d] = (unsigned short)f2bf(of[d] * rl2);
        }
        asm volatile("s_waitcnt lgkmcnt(0)" ::: "memory");
#endif
        const int ch = lane & 7; const int colg = 256 * ud.g + 64 * hh + 8 * ch;
        f32x4 cw[3][2];
#pragma unroll
        for (int k = 0; k < 3; ++k) { cw[k][0] = *(const GAS f32x4*)(F.conv_w + k * D + colg); cw[k][1] = *(const GAS f32x4*)(F.conv_w + k * D + colg + 4); }
        const int ni = ud.sample ? 2 : 4;
        for (int i = 0; i < ni; ++i) {
            const int lr = i * 8 + (lane >> 3), tok = half * 32 + lr;
            const size_t row = (size_t)ud.row0 + tok; const int t = ud.t0 + tok;
            const v4u ya = *(const LAS v4u*)(stg + lr * 64 + ch * 8);
            const v4u sg = *(const GAS v4u*)(F.SG + row * D + colg), bg = *(const GAS v4u*)(F.BG + row * D + colg);
            const v4u u0 = *(const GAS v4u*)(F.U + row * D + colg);
            float u1[8], u2[8];
            if (t >= 1) { const v4u w = *(const GAS v4u*)(F.U + (row - 1) * D + colg); u1[0] = bf_lo(w.x); u1[1] = bf_hi(w.x); u1[2] = bf_lo(w.y); u1[3] = bf_hi(w.y); u1[4] = bf_lo(w.z); u1[5] = bf_hi(w.z); u1[6] = bf_lo(w.w); u1[7] = bf_hi(w.w); }
            else if (ud.sample) { const float* sp = F.state_conv + (size_t)((ud.row0 - MP) / DEC_T * 2 + 1) * D + colg; const f32x4 a = *(const GAS f32x4*)sp, b = *(const GAS f32x4*)(sp + 4); u1[0] = a.x; u1[1] = a.y; u1[2] = a.z; u1[3] = a.w; u1[4] = b.x; u1[5] = b.y; u1[6] = b.z; u1[7] = b.w; }
            else {
#pragma unroll
                for (int e = 0; e < 8; ++e) u1[e] = 0.f; }
            if (t >= 2) { const v4u w = *(const GAS v4u*)(F.U + (row - 2) * D + colg); u2[0] = bf_lo(w.x); u2[1] = bf_hi(w.x); u2[2] = bf_lo(w.y); u2[3] = bf_hi(w.y); u2[4] = bf_lo(w.z); u2[5] = bf_hi(w.z); u2[6] = bf_lo(w.w); u2[7] = bf_hi(w.w); }
            else if (ud.sample) { const float* sp = F.state_conv + (size_t)((ud.row0 - MP) / DEC_T * 2 + t) * D + colg; const f32x4 a = *(const GAS f32x4*)sp, b = *(const GAS f32x4*)(sp + 4); u2[0] = a.x; u2[1] = a.y; u2[2] = a.z; u2[3] = a.w; u2[4] = b.x; u2[5] = b.y; u2[6] = b.z; u2[7] = b.w; }
            else {
#pragma unroll
                for (int e = 0; e < 8; ++e) u2[e] = 0.f; }
            unsigned sgw[4] = {sg.x, sg.y, sg.z, sg.w}, bgw[4] = {bg.x, bg.y, bg.z, bg.w};
            const unsigned yaw[4] = {ya.x, ya.y, ya.z, ya.w}, u0w[4] = {u0.x, u0.y, u0.z, u0.w};
#if defined(PROBE_NAIVE_SG) || defined(PROBE_NAIVE_BG)
            {
                const bf16* xr = F.XN + row * D;
                float gv[8];
#pragma unroll 1
                for (int e = 0; e < 8; ++e) {
                    const int cc = colg + e;
#ifdef PROBE_NAIVE_SG
                    const bf16* w0 = F.Win_t + (size_t)(5632 + cc) * D; const bf16* w1 = w0;
#else
                    const bf16* w0 = F.Win_t + (size_t)(256 * (8 + (cc >> 7)) + (cc & 127)) * D; const bf16* w1 = w0 + (size_t)128 * D;
#endif
                    float a0 = 0.f, a1 = 0.f;
                    for (int k = 0; k < D; k += 8) {
                        const v4u xv = *(const GAS v4u*)(xr + k), wa = *(const GAS v4u*)(w0 + k), wb = *(const GAS v4u*)(w1 + k);
                        a0 += bf_lo(xv.x) * bf_lo(wa.x) + bf_hi(xv.x) * bf_hi(wa.x) + bf_lo(xv.y) * bf_lo(wa.y) + bf_hi(xv.y) * bf_hi(wa.y) + bf_lo(xv.z) * bf_lo(wa.z) + bf_hi(xv.z) * bf_hi(wa.z) + bf_lo(xv.w) * bf_lo(wa.w) + bf_hi(xv.w) * bf_hi(wa.w);
                        a1 += bf_lo(xv.x) * bf_lo(wb.x) + bf_hi(xv.x) * bf_hi(wb.x) + bf_lo(xv.y) * bf_lo(wb.y) + bf_hi(xv.y) * bf_hi(wb.y) + bf_lo(xv.z) * bf_lo(wb.z) + bf_hi(xv.z) * bf_hi(wb.z) + bf_lo(xv.w) * bf_lo(wb.w) + bf_hi(xv.w) * bf_hi(wb.w);
                    }
#ifdef PROBE_NAIVE_SG
                    gv[e] = pg8::sigmoid_f(a0);
#else
                    gv[e] = a0 * pg8::sigmoid_f(a1);
#endif
                }
#ifdef PROBE_SG_COUNT
                {   unsigned nb = 0;
#pragma unroll
                    for (int e = 0; e < 8; ++e) { const float st = (e & 1) ? bf_hi(sgw[e >> 1]) : bf_lo(sgw[e >> 1]); if (!(fabsf(st - gv[e]) < 0.03f) && PROBE_SG_CAT) ++nb; }
                    atomicAdd((unsigned*)F.ctl + 2060, nb); atomicAdd((unsigned*)F.ctl + 2061, 8u); }
#endif
#pragma unroll
                for (int e = 0; e < 8; e += 2) {
#ifdef PROBE_NAIVE_SG
                    sgw[e >> 1] = cvtpk(gv[e], gv[e + 1]);
#else
                    bgw[e >> 1] = cvtpk(gv[e], gv[e + 1]);
#endif
                }
            }
#endif
            float mo[8];
#pragma unroll
            for (int e = 0; e < 8; ++e) {
                const unsigned sh = e >> 1; const bool hi16 = e & 1;
                const float yv = hi16 ? bf_hi(yaw[sh]) : bf_lo(yaw[sh]), sv = hi16 ? bf_hi(sgw[sh]) : bf_lo(sgw[sh]), bv = hi16 ? bf_hi(bgw[sh]) : bf_lo(bgw[sh]), uv = hi16 ? bf_hi(u0w[sh]) : bf_lo(u0w[sh]);
                const float conv = cw[0][e >> 2][e & 3] * u2[e] + cw[1][e >> 2][e & 3] * u1[e] + cw[2][e >> 2][e & 3] * uv;
                mo[e] = bv * conv * PS_CONV + sv * yv * PS_ATT;
            }
            v4u w; w.x = cvtpk(mo[0], mo[1]); w.y = cvtpk(mo[2], mo[3]); w.z = cvtpk(mo[4], mo[5]); w.w = cvtpk(mo[6], mo[7]);
            *(GAS v4u*)(F.MG + row * D + colg) = w;
        }
    }
    __syncthreads();
}

__device__ __forceinline__ void make_prompt_unit(Frame& F, int id, UnitDesc& ud) {
    const int bg = id >> 7, c = id & 127, b = bg >> 2, g = bg & 3;
    ud.g = g; ud.sample = 0; ud.row0 = b * SEQ_T + 64 * c; ud.t0 = 64 * c;
#pragma unroll
    for (int j = 0; j < 3; ++j) { const int cc = c - 2 + j; const int cl = cc < 0 ? 0 : cc; ud.nv[j] = cc < 0 ? 0 : 64;
        const size_t off = (size_t)(b * SEQ_T + 64 * cl) * 256 + 64 * g; ud.kt[j] = F.KB + off; ud.vt[j] = F.VB + off; }
}
__device__ __forceinline__ void make_sample_unit(Frame& F, int id, UnitDesc& ud) {
    const int bs = id >> 2, g = id & 3;
    ud.g = g; ud.sample = 1; ud.row0 = MP + DEC_T * bs; ud.t0 = 0;
    ud.nv[0] = 64; ud.nv[1] = 64; ud.nv[2] = DEC_T;
    const size_t o0 = (size_t)(bs * CACHE_L) * 256 + 64 * g, o2 = (size_t)(MP + DEC_T * bs) * 256 + 64 * g;
    ud.kt[0] = F.CK + o0; ud.vt[0] = F.CV + o0; ud.kt[1] = F.CK + o0 + 64 * 256; ud.vt[1] = F.CV + o0 + 64 * 256; ud.kt[2] = F.KB + o2; ud.vt[2] = F.VB + o2;
}
__device__ __forceinline__ void attn_phase(Frame& F) {
    constexpr int NPU = NB * 4 * NCH;
    const int per = (NPU + F.G - 1) / F.G;
    UnitDesc ud;
    for (int k = 0; k < per; ++k) { const int id = F.vcu * per + k; if (id >= NPU) break; make_prompt_unit(F, id, ud); attn_unit(F, ud); }
    for (int id = F.vcu; id < DEC_B * 4; id += F.G) { make_sample_unit(F, id, ud); attn_unit(F, ud); }
}
}

#ifndef MK_N_LAUNCHES
#define MK_N_LAUNCHES 1
#endif
constexpr int N_LAUNCHES = MK_N_LAUNCHES;
constexpr int PER_PHASE = 6;
struct Args { const float* in[16]; float* out; unsigned char* ws; int ph_lo, ph_hi, li, pad; };
__global__ void __launch_bounds__(NWAVES * 64, 2) mk_fwd(Args args) {
    extern __shared__ __attribute__((aligned(16))) unsigned char lds[];
    Frame F;
    F.lds = (LAS unsigned char*)lds;
    F.MISC = (volatile LAS unsigned*)(F.lds + MISC_OFF);
    F.tid = threadIdx.x; F.lane = F.tid & 63; F.wave = __builtin_amdgcn_readfirstlane(F.tid >> 6);
    F.G = gridDim.x; { const int bx = blockIdx.x; F.vcu = (F.G % 8 == 0) ? (bx % 8) * (F.G / 8) + bx / 8 : bx; }
    unsigned char* ws = args.ws;
    F.ctl = (gu32*)(ws + WS_CTL);
    F.xp = args.in[0]; F.xs = args.in[1]; F.state_conv = args.in[2]; F.cache_k = args.in[3]; F.cache_v = args.in[4]; F.norm_mix_w = args.in[5]; F.w_in = args.in[6]; F.conv_w = args.in[7];
    F.q_norm_w = args.in[8]; F.k_norm_w = args.in[9]; F.sinks = args.in[10]; F.w_out = args.in[11]; F.norm_ffn_w = args.in[12]; F.w_gate = args.in[13]; F.w_up = args.in[14]; F.w_down = args.in[15];
    F.out = args.out;
    F.Win_t = (bf16*)(ws + WS_WIN); F.Wout_t = (bf16*)(ws + WS_WOUT); F.Wgu_t = (bf16*)(ws + WS_WGU); F.Wd_t = (bf16*)(ws + WS_WD);
    F.XN = (bf16*)(ws + WS_XN);
#if defined(PROBE_NAIVE_SG) || defined(PROBE_NAIVE_BG)
    F.MG = (bf16*)(ws + 400 * MiB);
#else
    F.MG = (bf16*)(ws + WS_XN);
#endif
    F.Q = (bf16*)(ws + WS_Q); F.X1B = (bf16*)(ws + WS_Q); F.KB = (bf16*)(ws + WS_K); F.VB = (bf16*)(ws + WS_V);
    F.U = (bf16*)(ws + WS_U); F.BG = (bf16*)(ws + WS_BG); F.SG = (bf16*)(ws + WS_SG); F.H = (bf16*)(ws + WS_H); F.CK = (bf16*)(ws + WS_CK); F.CV = (bf16*)(ws + WS_CV);
    F.SS = (float*)(ws + WS_SS);
    for (int u = F.tid; u < (LDS_BYTES - LDSCTL_OFF) / 4; u += NWAVES * 64) ((LAS unsigned*)(F.lds + LDSCTL_OFF))[u] = 0u;
    __syncthreads();
    XcdBarrier bar; bar.bar = (unsigned*)(F.ctl + CW_BAR); bar.x = 0; bar.st = nullptr;
    if (N_LAUNCHES != PER_PHASE) bar = xcd_barrier_post((unsigned*)(F.ctl + CW_BAR), F.MISC + 8);
#define GRID_BAR() do { if (N_LAUNCHES != PER_PHASE) xcd_barrier(bar); } while (0)
    const int lo = args.ph_lo, hi = args.ph_hi;
#define IN(k) (lo <= (k) && (k) < hi)
#define BOTH(k) (IN(k) && IN((k) + 1))

    if (IN(0)) { p0_prologue(F); if (BOTH(0)) GRID_BAR(); }

    if (IN(1)) {
        pg8::Gemm g{F.XN, F.Win_t, MROWS, NIN, D}; pg8::StaticOrder S; S.init(MROWS, NIN, F.G, (int)blockIdx.x);
        pg8::EpiIn E{ws, F.q_norm_w, F.k_norm_w, F.out};
        pg8::gemm_phase<pg8::EpiIn, pg8::StaticOrder, true, true>(F.lds + RING_OFF, g, S, E);
        if (BOTH(1)) GRID_BAR();
    }
    if (IN(2)) { p2::attn_phase(F); if (BOTH(2)) GRID_BAR(); }
    if (IN(3)) {
        pg8::Gemm g{F.MG, F.Wout_t, MROWS, D, D}; pg8::StaticOrder S; S.init(MROWS, D, F.G, (int)blockIdx.x);
        pg8::EpiOut E{F.xp, F.xs, F.out + pg8::OUT_Y, F.X1B, F.SS};
        pg8::gemm_phase<pg8::EpiOut, pg8::StaticOrder, true, true>(F.lds + RING_OFF, g, S, E);
        if (BOTH(3)) GRID_BAR();
    }
    if (IN(4)) {
        pg8::Gemm g{F.X1B, F.Wgu_t, MROWS, NGU, D}; pg8::StaticOrder S; S.init(MROWS, NGU, F.G, (int)blockIdx.x);
        pg8::EpiGU E{F.SS, F.H};
        pg8::gemm_phase<pg8::EpiGU, pg8::StaticOrder, true, true>(F.lds + RING_OFF, g, S, E);
        if (BOTH(4)) GRID_BAR();
    }
    if (IN(5)) {
        pg8::Gemm g{F.H, F.Wd_t, MROWS, D, DFF}; pg8::StaticOrder S; S.init(MROWS, D, F.G, (int)blockIdx.x);
        pg8::EpiDown E{F.out + pg8::OUT_Y, (const unsigned*)ws};
        pg8::gemm_phase<pg8::EpiDown, pg8::StaticOrder, true, true>(F.lds + RING_OFF, g, S, E);
    }
#undef IN
#undef BOTH
}

extern "C" void kernel_launch(void* const* d_in, const int* in_sizes, int n_in, void* d_out, int out_size, void* d_ws, size_t ws_size, hipStream_t stream) {
    static int grid = 0;
    if (grid == 0) {
        if (n_in != 16 || in_sizes[0] != MP * D || (size_t)out_size != pg8::OUT_TOTAL || ws_size < WS_END) {
            fprintf(stderr, "kernel_launch: shape mismatch: n_in %d in0 %d out %d ws %zu (need %zu); nothing launched\n", n_in, n_in > 0 ? in_sizes[0] : -1, out_size, ws_size, (size_t)WS_END); grid = -1; return; }
        int dev = 0, cus = 0, per_cu = 0;
        if (hipGetDevice(&dev) != hipSuccess || hipDeviceGetAttribute(&cus, hipDeviceAttributeMultiprocessorCount, dev) != hipSuccess) { fprintf(stderr, "kernel_launch: device query failed\n"); grid = -1; return; }
        if (hipFuncSetAttribute((const void*)mk_fwd, hipFuncAttributeMaxDynamicSharedMemorySize, LDS_BYTES) != hipSuccess) { fprintf(stderr, "kernel_launch: hipFuncSetAttribute failed\n"); grid = -1; return; }
        if (hipOccupancyMaxActiveBlocksPerMultiprocessor(&per_cu, (const void*)mk_fwd, NWAVES * 64, LDS_BYTES) != hipSuccess || per_cu < 1) { fprintf(stderr, "kernel_launch: occupancy query reports %d blocks per CU\n", per_cu); (void)hipGetLastError(); per_cu = 1; }
        grid = cus;
        if (grid % 8 != 0) grid -= grid % 8;
    }
    if (grid < 0) return;
    if (hipMemsetAsync((char*)d_ws + WS_CTL, 0, CTL_ZERO_BYTES, stream) != hipSuccess) { fprintf(stderr, "kernel_launch: memset failed\n"); return; }
    Args a{};
    for (int i = 0; i < 16; ++i) a.in[i] = (const float*)d_in[i];
    a.out = (float*)d_out; a.ws = (unsigned char*)d_ws;
    for (int li = 0; li < N_LAUNCHES; ++li) {
        a.ph_lo = (N_LAUNCHES == PER_PHASE) ? li : 0; a.ph_hi = (N_LAUNCHES == PER_PHASE) ? li + 1 : PER_PHASE; a.li = li;
        hipLaunchKernelGGL(mk_fwd, dim3(grid), dim3(NWAVES * 64), LDS_BYTES, stream, a);
        const hipError_t le = hipPeekAtLastError();
        if (le != hipSuccess) { fprintf(stderr, "kernel_launch: launch %d failed: %s\n", li, hipGetErrorName(le)); break; }
    }
}
```

```cpp
#include <hip/hip_runtime.h>
#include <cstdio>
#include <cstdint>
namespace pg8 {
#define PG8_LAS __attribute__((address_space(3)))
typedef unsigned short bf16_t;
typedef short bf16x8 __attribute__((ext_vector_type(8)));
typedef float f32x4 __attribute__((ext_vector_type(4)));
typedef unsigned u32x4 __attribute__((ext_vector_type(4)));
constexpr int BM = 256, BK = 64, HALF = 128, HTB = HALF * BK * 2  , STAGE_BYTES = 8 * HTB, NXCD = 8, WGM = 8;

__host__ __device__ __forceinline__ int lds_byte(int r, int c) { const int st = (r >> 4) * 2 + (c >> 5), rr = r & 15, cc = c & 31, ob = rr * 64 + cc * 2; return st * 1024 + (ob ^ (((ob >> 9) & 1) << 5)); }
__host__ __device__ __forceinline__ void stage_rc(int b, int& R, int& C) { const int st = b / 1024, sb = b % 1024, swz = sb ^ (((sb >> 9) & 1) << 5); R = (st >> 1) * 16 + swz / 64; C = (st & 1) * 32 + (swz % 64) / 2; }
__host__ __device__ __forceinline__ int perm32(int rho) { const int n = rho >> 4, i = rho & 15; return 8 * (i >> 2) + 4 * n + (i & 3); }

struct Unit { int pm, pn; };
struct Gemm { const bf16_t* A; const bf16_t* Bt; int M, N, K; int amask = -1, bmask = -1; };

struct StaticOrder {
    int nM, nN, nwg, G, c;
    __host__ __device__ void init(int M, int N, int G_, int c_) { nM = M / BM; nN = N / BM; nwg = nM * nN; G = G_; c = c_; }
    __host__ __device__ bool next(int i, Unit& u) const {
        const long L = (long)i * G + c; if (L >= nwg) return false;
        int wgid = (int)L; { const int q = nwg / NXCD, r = nwg % NXCD, xcd = wgid % NXCD, off = wgid / NXCD; wgid = (xcd < r ? xcd * (q + 1) : r * (q + 1) + (xcd - r) * q) + off; }
        const int nig = WGM * nN, gid = wgid / nig, fm = gid * WGM, gsz = (nM - fm) < WGM ? (nM - fm) : WGM;
        u.pm = fm + ((wgid % nig) % gsz); u.pn = (wgid % nig) / gsz; return true;
    }
    __device__ __forceinline__ void a_ready(const Unit&) const {}
    __device__ __forceinline__ void done(const Unit&) const {}
};
struct Order {
    int nM, nN, nwg, L0, stride, count, mode, pm_fixed, rev;
    __device__ __forceinline__ void grid(int M, int N, int L0_, int stride_, int count_, int rev_ = 0) { nM = M / BM; nN = N / BM; nwg = nM * nN; L0 = L0_; stride = stride_; count = count_; mode = 0; pm_fixed = 0; rev = rev_; }
    __device__ __forceinline__ void panel(int pm, int N, int L0_, int stride_) { nM = 1; nN = N / BM; nwg = nN; L0 = L0_; stride = stride_; count = 1 << 30; mode = 1; pm_fixed = pm; rev = 0; }
    __device__ __forceinline__ bool next(int i, Unit& u) const {
        if (i >= count) return false;
        const long L = (long)i * stride + L0; if (L >= nwg) return false;
        if (mode == 1) { u.pm = pm_fixed; u.pn = (int)L; return true; }
        int wgid = (int)L; { const int q = nwg / NXCD, r = nwg % NXCD, xcd = wgid % NXCD, off = wgid / NXCD;
            const int clen = xcd < r ? q + 1 : q, cst = xcd < r ? xcd * (q + 1) : r * (q + 1) + (xcd - r) * q;
            wgid = cst + (rev ? clen - 1 - off : off); }
        const int nig = WGM * nN, gid = wgid / nig, fm = gid * WGM, gsz = (nM - fm) < WGM ? (nM - fm) : WGM;
        u.pm = fm + ((wgid % nig) % gsz); u.pn = (wgid % nig) / gsz; return true;
    }
    __device__ __forceinline__ void a_ready(const Unit&) const {}
    __device__ __forceinline__ void done(const Unit&) const {}
};

typedef float f32x2_t __attribute__((ext_vector_type(2))); typedef __bf16 bf16x2_t __attribute__((ext_vector_type(2)));
__device__ __forceinline__ unsigned cvt_pk_bf16(float lo, float hi) { f32x2_t v = {lo, hi}; bf16x2_t b = __builtin_convertvector(v, bf16x2_t); return __builtin_bit_cast(unsigned, b); }
__device__ __forceinline__ float sigmoid_f(float x) { return __builtin_amdgcn_rcpf(1.0f + __builtin_amdgcn_exp2f(-1.4426950408889634f * x)); }
__device__ __forceinline__ f32x4 sigmoid4(const f32x4& x) {
    const f32x4 t = x * -1.4426950408889634f; f32x4 e, s;
#pragma unroll
    for (int j = 0; j < 4; ++j) e[j] = __builtin_amdgcn_exp2f(t[j]);
    e = e + (f32x4){1.f, 1.f, 1.f, 1.f};
#pragma unroll
    for (int j = 0; j < 4; ++j) s[j] = __builtin_amdgcn_rcpf(e[j]);
    return s;
}
__device__ __forceinline__ f32x4 sigmoid255(const f32x4& x) {
    const f32x4 t = x * -1.4426950408889634f; f32x4 e, s;
#pragma unroll
    for (int j = 0; j < 4; ++j) e[j] = __builtin_amdgcn_exp2f(t[j]);
    e = e * (1.0f / 255.0f) + (f32x4){1.0f / 255.0f, 1.0f / 255.0f, 1.0f / 255.0f, 1.0f / 255.0f};
#pragma unroll
    for (int j = 0; j < 4; ++j) s[j] = __builtin_amdgcn_rcpf(e[j]);
    return s;
}
__device__ __forceinline__ u32x4 pack8(const f32x4& a, const f32x4& b) { u32x4 w; w.x = cvt_pk_bf16(a[0], a[1]); w.y = cvt_pk_bf16(a[2], a[3]); w.z = cvt_pk_bf16(b[0], b[1]); w.w = cvt_pk_bf16(b[2], b[3]); return w; }

constexpr int MROWS = 33024, MP = 32768, SEQ_T = 8192;
constexpr float RMS_EPS = 1e-6f;
constexpr size_t EO_Q = 105ull << 20, EO_K = 170ull << 20, EO_V = 187ull << 20, EO_U = 204ull << 20, EO_BG = 269ull << 20, EO_SG = 334ull << 20;
constexpr float QSCALE = 0.125f * 1.4426950408889634f;
constexpr size_t OUT_Y = 0, OUT_CONVP = 33816576, OUT_KP = 33824768, OUT_VP = 33955840, OUT_CONVS = 34086912, OUT_KS = 34119680, OUT_VS = 34185216, OUT_TOTAL = 34250752;

struct EpiIn {
    static constexpr bool PERM = true, AFTER_DRAIN = false;
    unsigned char* ws; const float *qw, *kw; float* out;
    struct Pre {}; __device__ __forceinline__ void prefetch(const Unit&, Pre&, int, int, int) const {}
    __device__ __forceinline__ void operator()(const f32x4 (&acc)[2][2][4][2], const Unit& u, int wr, int wc, int fr, int fq, const Pre&) const {
        asm volatile("" : "+v"(fr), "+v"(fq), "+s"(wr), "+s"(wc));
        const int pn = u.pn, pm = u.pm;
        bf16_t* const U = (bf16_t*)(ws + EO_U); bf16_t* const BG = (bf16_t*)(ws + EO_BG); bf16_t* const SG = (bf16_t*)(ws + EO_SG);
        bf16_t* const Q = (bf16_t*)(ws + EO_Q); bf16_t* const K = (bf16_t*)(ws + EO_K); bf16_t* const V = (bf16_t*)(ws + EO_V);
        const int lrow0 = wr * 64 + fr;
        const size_t grow0 = (size_t)pm * BM + lrow0;
        if (pn < 16) {
            const bool isU = pn < 8; const int p = isU ? pn : pn - 8;
            bf16_t* O = isU ? U : BG;
            const int col = 128 * p + 32 * wc + 8 * fq;
#pragma unroll
            for (int ai = 0; ai < 2; ++ai)
#pragma unroll
                for (int m = 0; m < 4; ++m) {
                    f32x4 a0 = acc[ai][0][m][0], a1 = acc[ai][0][m][1], b0 = acc[ai][1][m][0], b1 = acc[ai][1][m][1];
                    f32x4 r0, r1;
                    if (isU) { r0 = a0 * b0; r1 = a1 * b1; }
                    else {
#pragma unroll
                        for (int j = 0; j < 1; ++j) { r0 = a0 * sigmoid4(b0); r1 = a1 * sigmoid4(b1); }
                    }
                    const size_t row = grow0 + ai * HALF + m * 16;
                    *(u32x4*)(O + row * 1024 + col) = pack8(r0, r1);
                    if (isU && fr >= 14) {
                        float* dst = nullptr;
                        if (pm == 128) dst = out + OUT_CONVS + (size_t)((8 * ai + 4 * wr + m) * 2 + (fr - 14)) * 1024 + col;
                        else if ((pm & 31) == 31 && ai == 1 && wr == 1 && m == 3) dst = out + OUT_CONVP + (size_t)((pm >> 5) * 2 + (fr - 14)) * 1024 + col;
                        if (dst) { *(f32x4*)dst = r0; *(f32x4*)(dst + 4) = r1; }
                    }
                }
        } else if (pn < 22) {
            const bool isQ = pn < 20, isK = pn == 20;
            const float* nw = isQ ? qw : kw; asm volatile("" : "+s"(nw));
            f32x4 w[2][2];
#pragma unroll
            for (int bj = 0; bj < 2; ++bj)
#pragma unroll
                for (int n = 0; n < 2; ++n) {
                    if (pn == 21) w[bj][n] = (f32x4){1.f, 1.f, 1.f, 1.f};
                    else { w[bj][n] = *(const __attribute__((address_space(1))) f32x4*)(nw + 32 * bj + 8 * fq + 4 * n); if (isQ) w[bj][n] = w[bj][n] * QSCALE; }
                }
            bf16_t* O = isQ ? Q : (isK ? K : V); const int ldo = isQ ? 1024 : 256;
            const int col = (isQ ? 256 * (pn - 16) : 0) + 64 * wc + 8 * fq;
            float* o32p = out + (isK ? OUT_KP : OUT_VP); float* o32s = out + (isK ? OUT_KS : OUT_VS);
#pragma unroll
            for (int ai = 0; ai < 2; ++ai)
#pragma unroll
                for (int m = 0; m < 4; ++m) {
                    f32x4 v[2][2];
#pragma unroll
                    for (int bj = 0; bj < 2; ++bj)
#pragma unroll
                        for (int n = 0; n < 2; ++n) v[bj][n] = acc[ai][bj][m][n];
                    if (pn != 21) {
                        float ss = 0.f;
#pragma unroll
                        for (int bj = 0; bj < 2; ++bj)
#pragma unroll
                            for (int n = 0; n < 2; ++n) { const f32x4 x = v[bj][n]; ss += (x[0] * x[0] + x[1] * x[1]) + (x[2] * x[2] + x[3] * x[3]); }
                        ss += __shfl_xor(ss, 16); ss += __shfl_xor(ss, 32);
                        const float rs = __builtin_amdgcn_rsqf(ss * (1.0f / 64.0f) + RMS_EPS);
#pragma unroll
                        for (int bj = 0; bj < 2; ++bj)
#pragma unroll
                            for (int n = 0; n < 2; ++n) v[bj][n] = v[bj][n] * rs * w[bj][n];
                    }
                    const int lrow = lrow0 + ai * HALF + m * 16;
                    const size_t row = (size_t)pm * BM + lrow;
#pragma unroll
                    for (int bj = 0; bj < 2; ++bj) *(u32x4*)(O + row * ldo + col + 32 * bj) = pack8(v[bj][0], v[bj][1]);
                    if (!isQ) {
                        float* dst = nullptr;
                        if (pm == 128) dst = o32s + (size_t)lrow * 256 + col;
                        else if ((pm & 31) == 31 && ai == 1) dst = o32p + (size_t)((pm >> 5) * 128 + (lrow - 128)) * 256 + col;
                        if (dst) {
#pragma unroll
                            for (int bj = 0; bj < 2; ++bj) { *(f32x4*)(dst + 32 * bj) = v[bj][0]; *(f32x4*)(dst + 32 * bj + 4) = v[bj][1]; }
                        }
                    }
                }
        } else {
            const int col = 256 * (pn - 22) + 32 * wc + 8 * fq;
#pragma unroll
            for (int ai = 0; ai < 2; ++ai)
#pragma unroll
                for (int m = 0; m < 4; ++m) {
                    const size_t row = grow0 + ai * HALF + m * 16;
#pragma unroll
                    for (int bj = 0; bj < 2; ++bj) {
                        f32x4 r0, r1;
#pragma unroll
                        for (int j = 0; j < 1; ++j) { r0 = sigmoid255(acc[ai][bj][m][0]); r1 = sigmoid255(acc[ai][bj][m][1]); }
                        unsigned w0 = 0u, w1 = 0u;
                        w0 = __builtin_amdgcn_cvt_pk_u8_f32(r0[0], 0, w0); w0 = __builtin_amdgcn_cvt_pk_u8_f32(r0[1], 1, w0); w0 = __builtin_amdgcn_cvt_pk_u8_f32(r0[2], 2, w0); w0 = __builtin_amdgcn_cvt_pk_u8_f32(r0[3], 3, w0);
                        w1 = __builtin_amdgcn_cvt_pk_u8_f32(r1[0], 0, w1); w1 = __builtin_amdgcn_cvt_pk_u8_f32(r1[1], 1, w1); w1 = __builtin_amdgcn_cvt_pk_u8_f32(r1[2], 2, w1); w1 = __builtin_amdgcn_cvt_pk_u8_f32(r1[3], 3, w1);
                        typedef unsigned u32x2_t __attribute__((ext_vector_type(2)));
                        *(u32x2_t*)((unsigned char*)SG + row * 1024 + col + 128 * bj) = (u32x2_t){w0, w1};
                    }
                }
        }
    }
};

#ifndef NT_Y
#define NT_Y 0
#endif
#ifndef NT_XN
#define NT_XN 1
#endif
#ifndef NT_X1B
#define NT_X1B 1
#endif
#define NT_IFE(c, p) ((c) ? __builtin_nontemporal_load(p) : *(p))
#if NT_Y
#define NT_STORE(p, v) __builtin_nontemporal_store((v), (p))
#else
#define NT_STORE(p, v) (*(p) = (v))
#endif
struct EpiOut {
    static constexpr bool PERM = true, AFTER_DRAIN = false;
    const bf16_t* XN; const float* IR; const float* nw; bf16_t* X1B; float* SS; PG8_LAS float* ssbuf;
    struct Pre {}; __device__ __forceinline__ void prefetch(const Unit&, Pre&, int, int, int) const {}
    __device__ __forceinline__ void operator()(const f32x4 (&acc)[2][2][4][2], const Unit& u, int wr, int wc, int fr, int fq, const Pre&) const {
        asm volatile("" : "+v"(fr), "+v"(fq), "+s"(wr), "+s"(wc));
        const int pm = u.pm; const int col = 256 * u.pn + 32 * wc + 8 * fq;
        const int lrow0 = wr * 64 + fr;
        f32x4 iw[2][2];
#pragma unroll
        for (int bj = 0; bj < 2; ++bj)
#pragma unroll
            for (int n = 0; n < 2; ++n) { const f32x4 w4 = *(const __attribute__((address_space(1))) f32x4*)(nw + col + 128 * bj + 4 * n);
#pragma unroll
                for (int j = 0; j < 4; ++j) iw[bj][n][j] = __builtin_amdgcn_rcpf(w4[j]); }
#pragma unroll
        for (int ai = 0; ai < 2; ++ai) {
            u32x4 xw[4][2]; float ir[4];
#pragma unroll
            for (int m = 0; m < 4; ++m) { const size_t row = (size_t)pm * BM + lrow0 + ai * HALF + m * 16; ir[m] = IR[row];
#pragma unroll
                for (int bj = 0; bj < 2; ++bj) xw[m][bj] = NT_IFE(NT_XN, (const __attribute__((address_space(1))) u32x4*)(XN + row * 1024 + col + 128 * bj)); }
            asm volatile("" ::: "memory");
#pragma unroll
            for (int m = 0; m < 4; ++m) {
                const int lrow = lrow0 + ai * HALF + m * 16; const size_t row = (size_t)pm * BM + lrow;
                float ss = 0.f;
#pragma unroll
                for (int bj = 0; bj < 2; ++bj) {
                    const u32x4 w = xw[m][bj]; f32x4 x0, x1;
                    x0[0] = __uint_as_float(w.x << 16); x0[1] = __uint_as_float(w.x & 0xffff0000u); x0[2] = __uint_as_float(w.y << 16); x0[3] = __uint_as_float(w.y & 0xffff0000u);
                    x1[0] = __uint_as_float(w.z << 16); x1[1] = __uint_as_float(w.z & 0xffff0000u); x1[2] = __uint_as_float(w.w << 16); x1[3] = __uint_as_float(w.w & 0xffff0000u);
                    const f32x4 y0 = x0 * iw[bj][0] * ir[m] + acc[ai][bj][m][0], y1 = x1 * iw[bj][1] * ir[m] + acc[ai][bj][m][1];
                    ss += (y0[0] * y0[0] + y0[1] * y0[1]) + (y0[2] * y0[2] + y0[3] * y0[3]) + (y1[0] * y1[0] + y1[1] * y1[1]) + (y1[2] * y1[2] + y1[3] * y1[3]);
                    *(u32x4*)(X1B + row * 1024 + col + 128 * bj) = pack8(y0, y1);
                }
                ss += __shfl_xor(ss, 16); ss += __shfl_xor(ss, 32);
                if (fq == 0) ssbuf[lrow * 4 + wc] = ss;
            }
        }
        asm volatile("s_waitcnt lgkmcnt(0)" ::: "memory"); __builtin_amdgcn_s_barrier(); asm volatile("" ::: "memory");
        { const int t = threadIdx.x; if (t < 256) { const float a = ssbuf[t * 4 + 0], b = ssbuf[t * 4 + 1], c = ssbuf[t * 4 + 2], d = ssbuf[t * 4 + 3]; SS[(size_t)u.pn * MROWS + (size_t)pm * BM + t] = (a + b) + (c + d); } }
        asm volatile("s_waitcnt lgkmcnt(0)" ::: "memory"); __builtin_amdgcn_s_barrier(); asm volatile("" ::: "memory");
    }
};

struct EpiGU {
    static constexpr bool PERM = true, AFTER_DRAIN = false;
    const float* SS; bf16_t* H;
    struct Pre { float sv[2][4]; };
    __device__ __forceinline__ void prefetch(const Unit& u, Pre& p, int wr, int fr, int fq) const {
#pragma unroll
        for (int ai = 0; ai < 2; ++ai)
#pragma unroll
            for (int m = 0; m < 4; ++m) p.sv[ai][m] = SS[(size_t)fq * MROWS + (size_t)u.pm * BM + wr * 64 + fr + ai * HALF + m * 16];
    }
    __device__ __forceinline__ void operator()(const f32x4 (&acc)[2][2][4][2], const Unit& u, int wr, int wc, int fr, int fq, const Pre& pre) const {
        asm volatile("" : "+v"(fr), "+v"(fq), "+s"(wr), "+s"(wc));
        const int col = 128 * u.pn + 32 * wc + 8 * fq; const int lrow0 = wr * 64 + fr;
#pragma unroll
        for (int ai = 0; ai < 2; ++ai)
#pragma unroll
            for (int m = 0; m < 4; ++m) {
                const size_t row = (size_t)u.pm * BM + lrow0 + ai * HALF + m * 16;
                float ss = pre.sv[ai][m];
                ss += __shfl_xor(ss, 16); ss += __shfl_xor(ss, 32);
                const float ms = ss * (1.0f / 1024.0f) + RMS_EPS; const float rs = __builtin_amdgcn_rsqf(ms);
                const float c1 = -1.4426950408889634f * rs;
                const f32x4 msv = {ms, ms, ms, ms};
                const f32x4 t0 = acc[ai][0][m][0] * c1, t1 = acc[ai][0][m][1] * c1;
                f32x4 e0, e1;
#pragma unroll
                for (int j = 0; j < 4; ++j) { e0[j] = __builtin_amdgcn_exp2f(t0[j]); e1[j] = __builtin_amdgcn_exp2f(t1[j]); }
                e0 = e0 * ms + msv; e1 = e1 * ms + msv;
                f32x4 s0, s1;
#pragma unroll
                for (int j = 0; j < 4; ++j) { s0[j] = __builtin_amdgcn_rcpf(e0[j]); s1[j] = __builtin_amdgcn_rcpf(e1[j]); }
                const f32x4 r0 = (acc[ai][0][m][0] * acc[ai][1][m][0]) * s0, r1 = (acc[ai][0][m][1] * acc[ai][1][m][1]) * s1;
                *(u32x4*)(H + row * 2816 + col) = pack8(r0, r1);
            }
    }
};

struct EpiDown {
    static constexpr bool PERM = true, AFTER_DRAIN = false;
    float* Y; const bf16_t* X1B;
#ifdef EPI_TS
    unsigned long long* tsp;
#endif
    struct Pre {}; __device__ __forceinline__ void prefetch(const Unit&, Pre&, int, int, int) const {}
    __device__ __forceinline__ void operator()(const f32x4 (&acc)[2][2][4][2], const Unit& u, int wr, int wc, int fr, int fq, const Pre&) const {
        asm volatile("" : "+v"(fr), "+v"(fq), "+s"(wr), "+s"(wc));
        const int col = 256 * u.pn + 32 * wc + 8 * fq; const int lrow0 = wr * 64 + fr;
#ifdef EPI_TS
        const unsigned long long ts0 = __builtin_amdgcn_s_memrealtime();
#endif
        u32x4 xw[2][4][2];
#pragma unroll
        for (int ai = 0; ai < 2; ++ai)
#pragma unroll
            for (int m = 0; m < 4; ++m) { const size_t off = ((size_t)u.pm * BM + lrow0 + ai * HALF + m * 16) * 1024 + col;
#pragma unroll
                for (int bj = 0; bj < 2; ++bj) xw[ai][m][bj] = NT_IFE(NT_X1B, (const __attribute__((address_space(1))) u32x4*)(X1B + off + 128 * bj)); }
        asm volatile("" ::: "memory");
#ifdef EPI_TS
        asm volatile("s_waitcnt vmcnt(0)" ::: "memory"); const unsigned long long ts1 = __builtin_amdgcn_s_memrealtime();
#endif
#pragma unroll
        for (int ai = 0; ai < 2; ++ai)
#pragma unroll
            for (int m = 0; m < 4; ++m) {
                const size_t off = ((size_t)u.pm * BM + lrow0 + ai * HALF + m * 16) * 1024 + col;
#pragma unroll
                for (int bj = 0; bj < 2; ++bj) {
                    const u32x4 w = xw[ai][m][bj];
                    f32x4 x0, x1;
                    x0[0] = __uint_as_float(w.x << 16); x0[1] = __uint_as_float(w.x & 0xffff0000u); x0[2] = __uint_as_float(w.y << 16); x0[3] = __uint_as_float(w.y & 0xffff0000u);
                    x1[0] = __uint_as_float(w.z << 16); x1[1] = __uint_as_float(w.z & 0xffff0000u); x1[2] = __uint_as_float(w.w << 16); x1[3] = __uint_as_float(w.w & 0xffff0000u);
                    NT_STORE((f32x4*)(Y + off + 128 * bj), x0 + acc[ai][bj][m][0]); NT_STORE((f32x4*)(Y + off + 128 * bj + 4), x1 + acc[ai][bj][m][1]);
                }
            }
#ifdef EPI_TS
        asm volatile("s_waitcnt vmcnt(0)" ::: "memory"); const unsigned long long ts2 = __builtin_amdgcn_s_memrealtime();
        if (threadIdx.x == 0 && u.pm < 128) { unsigned long long* tp = tsp + 2048; tp[blockIdx.x] += ts1 - ts0; tp[256 + blockIdx.x] += ts2 - ts1; const unsigned long long n = tp[512 + blockIdx.x]; tp[512 + blockIdx.x] = n + 1; if (n < 2) { tp[1024 + blockIdx.x * 4 + n * 2] = ts0; tp[1024 + blockIdx.x * 4 + n * 2 + 1] = ts2; } }
#endif
    }
};
template <class Epi, class Sched, bool ALIGN_EPI = false, bool SP2 = false, int AUXA = 0  >
__device__ __forceinline__ void gemm_phase(PG8_LAS unsigned char* lds, const Gemm g, const Sched& S, const Epi& E) {
    int tid_ = threadIdx.x; asm volatile("" : "+v"(tid_));
    const int tid = tid_, wid = __builtin_amdgcn_readfirstlane(tid >> 6), lane = tid & 63, wr = wid >> 2, wc = wid & 3, fr = lane & 15, fq = lane >> 4;
    const int K = g.K, nt = K / BK;
    unsigned voffA[2], voffB[2];
#pragma unroll
    for (int i = 0; i < 2; ++i) { int R, C; stage_rc(tid * 16 + i * 8192, R, C); const int Rb = Epi::PERM ? ((R & ~31) + perm32(R & 31)) : R;
        voffA[i] = (unsigned)(R * K + C) * 2u; voffB[i] = (unsigned)(Rb * K + C) * 2u; }
    const size_t kstep = (size_t)(BK * 2);
    const size_t hstep = (size_t)HALF * K * 2;
    const size_t tstep = 2 * hstep;
    const unsigned ldsw = (unsigned)wid * 1024u;
    const int aoff = lds_byte(wr * 64 + fr, fq * 8), boff = lds_byte(wc * 32 + fr, fq * 8);
#define PG8_SA(b, h) (((b) * 2 + (h)) * HTB)
#define PG8_SB(b, h) ((4 + (b) * 2 + (h)) * HTB)
#define PG8_STAGE_X(bufoff, gbase, voff, AUX_) do { _Pragma("unroll") for (int _i = 0; _i < 2; ++_i) \
        __builtin_amdgcn_global_load_lds((const unsigned*)((const char*)(gbase) + (voff)[_i]), (PG8_LAS unsigned*)(lds + (bufoff) + ldsw + _i * 8192), 16, 0, AUX_); } while (0)
#define PG8_STAGE(bufoff, gbase, voff) do { if constexpr (AUXA == 2) { if (&(voff) == &voffA) PG8_STAGE_X(bufoff, gbase, voff, 2); else PG8_STAGE_X(bufoff, gbase, voff, 0); } else PG8_STAGE_X(bufoff, gbase, voff, 0); } while (0)
#define PG8_LDA(dst, b, h) do { _Pragma("unroll") for (int m = 0; m < 4; ++m) _Pragma("unroll") for (int k = 0; k < 2; ++k) dst[m][k] = *(const PG8_LAS bf16x8*)(lds + PG8_SA(b, h) + aoff + m * 2048 + k * 1024); } while (0)
#define PG8_LDB(dst, b, h) do { _Pragma("unroll") for (int n = 0; n < 2; ++n) _Pragma("unroll") for (int k = 0; k < 2; ++k) dst[n][k] = *(const PG8_LAS bf16x8*)(lds + PG8_SB(b, h) + boff + n * 2048 + k * 1024); } while (0)
#define PG8_MMA(ai, bj, At, Bt) do { __builtin_amdgcn_s_setprio(1); _Pragma("unroll") for (int m = 0; m < 4; ++m) _Pragma("unroll") for (int n = 0; n < 2; ++n) _Pragma("unroll") for (int k = 0; k < 2; ++k) \
        acc[ai][bj][m][n] = __builtin_amdgcn_mfma_f32_16x16x32_bf16(Bt[n][k], At[m][k], acc[ai][bj][m][n], 0, 0, 0); __builtin_amdgcn_s_setprio(0); } while (0)
#define PG8_WAIT_V(n) asm volatile("s_waitcnt vmcnt(" #n ")" ::: "memory")
#define PG8_WAIT_L(n) asm volatile("s_waitcnt lgkmcnt(" #n ")" ::: "memory")
#define PG8_BAR __builtin_amdgcn_s_barrier()
#define PG8_SCHED __builtin_amdgcn_sched_barrier(0)
    Unit cur, nxt; int ui = 0;
    if (!S.next(0, cur)) return;
    typename Epi::Pre pre;
    f32x4 acc[2][2][4][2];
#pragma unroll
    for (int a = 0; a < 2; ++a)
#pragma unroll
        for (int b = 0; b < 2; ++b)
#pragma unroll
            for (int m = 0; m < 4; ++m)
#pragma unroll
                for (int n = 0; n < 2; ++n) acc[a][b][m][n] = (f32x4){0.f, 0.f, 0.f, 0.f};
    bf16x8 At[4][2], B0[2][2], B1[2][2];
    const char* cA = (const char*)g.A + (size_t)(cur.pm & g.amask) * tstep; const char* cB = (const char*)g.Bt + (size_t)(cur.pn & g.bmask) * tstep;
    S.a_ready(cur);
    if constexpr (SP2) {
        PG8_STAGE(PG8_SB(0, 0), cB, voffB); PG8_STAGE(PG8_SB(0, 1), cB + hstep, voffB); PG8_STAGE(PG8_SA(0, 0), cA, voffA); PG8_STAGE(PG8_SA(0, 1), cA + hstep, voffA);
        if (wr == 1) PG8_BAR;
        PG8_WAIT_V(2); PG8_BAR;
        PG8_STAGE(PG8_SB(1, 0), cB + kstep, voffB); PG8_STAGE(PG8_SA(1, 0), cA + kstep, voffA); PG8_STAGE(PG8_SB(1, 1), cB + hstep + kstep, voffB);
        PG8_WAIT_V(6); PG8_BAR;
    } else {
        PG8_STAGE(PG8_SB(0, 0), cB, voffB); PG8_STAGE(PG8_SA(0, 0), cA, voffA); PG8_STAGE(PG8_SB(0, 1), cB + hstep, voffB); PG8_STAGE(PG8_SA(0, 1), cA + hstep, voffA);
        if (wr == 1) PG8_BAR;
        PG8_WAIT_V(4); PG8_BAR;
        PG8_STAGE(PG8_SB(1, 0), cB + kstep, voffB); PG8_STAGE(PG8_SA(1, 0), cA + kstep, voffA); PG8_STAGE(PG8_SB(1, 1), cB + hstep + kstep, voffB);
        PG8_WAIT_V(6); PG8_BAR;
    }
    for (;;) {
        const bool has_next = S.next(ui + 1, nxt);
        const char* nA = has_next ? (const char*)g.A + (size_t)(nxt.pm & g.amask) * tstep : cA; const char* nB = has_next ? (const char*)g.Bt + (size_t)(nxt.pn & g.bmask) * tstep : cB;
        for (int t = 0; t < nt; t += 2) {
            const bool last = (t == nt - 2);
            const char* a1 = cA + (size_t)(t + 1) * kstep;
            const char* a2 = last ? nA : cA + (size_t)(t + 2) * kstep; const char* b2 = last ? nB : cB + (size_t)(t + 2) * kstep;
            const char* a3 = a2 + kstep; const char* b3 = b2 + kstep;
            if (last && has_next) S.a_ready(nxt);
            if (last) E.prefetch(cur, pre, wr, fr, fq);
            if constexpr (SP2) {
            PG8_LDB(B0, 0, 0); PG8_LDB(B1, 0, 1); PG8_SCHED; PG8_LDA(At, 0, 0); PG8_STAGE(PG8_SA(1, 1), a1 + hstep, voffA);
            PG8_WAIT_V(8); PG8_WAIT_L(0); PG8_BAR; PG8_MMA(0, 0, At, B0); PG8_MMA(0, 1, At, B1); PG8_BAR; PG8_SCHED;
            PG8_LDA(At, 0, 1); PG8_STAGE(PG8_SB(0, 0), b2, voffB); PG8_STAGE(PG8_SB(0, 1), b2 + hstep, voffB); PG8_STAGE(PG8_SA(0, 0), a2, voffA);
            PG8_WAIT_V(8); PG8_WAIT_L(0); PG8_BAR; PG8_MMA(1, 0, At, B0); PG8_MMA(1, 1, At, B1); PG8_BAR; PG8_SCHED;
            PG8_LDB(B0, 1, 0); PG8_LDB(B1, 1, 1); PG8_SCHED; PG8_LDA(At, 1, 0); PG8_STAGE(PG8_SA(0, 1), a2 + hstep, voffA);
            PG8_WAIT_V(8); PG8_WAIT_L(0); PG8_BAR; PG8_MMA(0, 0, At, B0); PG8_MMA(0, 1, At, B1); PG8_BAR; PG8_SCHED;
            PG8_LDA(At, 1, 1); PG8_STAGE(PG8_SB(1, 0), b3, voffB); PG8_STAGE(PG8_SB(1, 1), b3 + hstep, voffB); PG8_STAGE(PG8_SA(1, 0), a3, voffA);
            PG8_WAIT_V(8); PG8_WAIT_L(0); PG8_BAR; PG8_MMA(1, 0, At, B0); PG8_MMA(1, 1, At, B1); PG8_BAR; PG8_SCHED;
            } else {
            PG8_LDB(B0, 0, 0); PG8_SCHED; PG8_LDA(At, 0, 0); PG8_STAGE(PG8_SA(1, 1), a1 + hstep, voffA);
            PG8_WAIT_L(8); PG8_BAR; PG8_WAIT_L(0); PG8_MMA(0, 0, At, B0); PG8_BAR; PG8_SCHED;
            PG8_LDB(B1, 0, 1); PG8_STAGE(PG8_SB(0, 0), b2, voffB);
            PG8_BAR; PG8_WAIT_L(0); PG8_MMA(0, 1, At, B1); PG8_BAR;
            PG8_LDA(At, 0, 1); PG8_STAGE(PG8_SA(0, 0), a2, voffA);
            PG8_BAR; PG8_WAIT_L(0); PG8_MMA(1, 0, At, B0); PG8_BAR; PG8_SCHED;
            PG8_STAGE(PG8_SB(0, 1), b2 + hstep, voffB);
            PG8_WAIT_V(6); PG8_BAR; PG8_MMA(1, 1, At, B1); PG8_BAR;
            PG8_LDB(B0, 1, 0); PG8_SCHED; PG8_LDA(At, 1, 0); PG8_STAGE(PG8_SA(0, 1), a2 + hstep, voffA);
            PG8_WAIT_L(8); PG8_BAR; PG8_WAIT_L(0); PG8_MMA(0, 0, At, B0); PG8_BAR; PG8_SCHED;
            PG8_LDB(B1, 1, 1); PG8_STAGE(PG8_SB(1, 0), b3, voffB);
            PG8_BAR; PG8_WAIT_L(0); PG8_MMA(0, 1, At, B1); PG8_BAR;
            PG8_LDA(At, 1, 1); PG8_STAGE(PG8_SA(1, 0), a3, voffA);
            PG8_BAR; PG8_WAIT_L(0); PG8_MMA(1, 0, At, B0); PG8_BAR; PG8_SCHED;
            PG8_STAGE(PG8_SB(1, 1), b3 + hstep, voffB);
            PG8_WAIT_V(6); PG8_BAR; PG8_MMA(1, 1, At, B1); PG8_BAR;
            }
        }
        if constexpr (ALIGN_EPI) { if (wr == 0) PG8_BAR; }
        if constexpr (!Epi::AFTER_DRAIN) { E(acc, cur, wr, wc, fr, fq, pre); S.done(cur); }
        if (!has_next) break;
#pragma unroll
        for (int a = 0; a < 2; ++a)
#pragma unroll
            for (int b = 0; b < 2; ++b)
#pragma unroll
                for (int m = 0; m < 4; ++m)
#pragma unroll
                    for (int n = 0; n < 2; ++n) acc[a][b][m][n] = (f32x4){0.f, 0.f, 0.f, 0.f};
        cur = nxt; cA = nA; cB = nB; ++ui;
        if constexpr (ALIGN_EPI) { if (wr == 1) PG8_BAR; }
    }
    PG8_WAIT_V(0);
    if constexpr (!ALIGN_EPI) { if (wr == 0) PG8_BAR; }
    PG8_BAR;
    if constexpr (Epi::AFTER_DRAIN) { E.fused(acc, cur, wr, wc, fr, fq, lds, wid, lane); S.done(cur); }
#undef PG8_SA
#undef PG8_SB
#undef PG8_STAGE
#undef PG8_STAGE_X
#undef PG8_LDA
#undef PG8_LDB
#undef PG8_MMA
#undef PG8_WAIT_V
#undef PG8_WAIT_L
#undef PG8_BAR
#undef PG8_SCHED
}
}
#define GAS __attribute__((address_space(1)))
#define LAS __attribute__((address_space(3)))
typedef unsigned short bf16;
typedef unsigned v4u __attribute__((ext_vector_type(4)));
typedef float f32x4 __attribute__((ext_vector_type(4)));
typedef short bf16x8 __attribute__((ext_vector_type(8)));
typedef GAS unsigned gu32;
typedef GAS unsigned long long gu64;
#define RLX_AGENT __ATOMIC_RELAXED, __HIP_MEMORY_SCOPE_AGENT
#define LDS_WAIT() asm volatile("s_waitcnt lgkmcnt(0)" ::: "memory")
#define VM_WAIT() asm volatile("s_waitcnt vmcnt(0)" ::: "memory")
__device__ __forceinline__ unsigned long long rt() { return __builtin_amdgcn_s_memrealtime(); }
__device__ __forceinline__ unsigned f2bf(float f) { unsigned u = __builtin_bit_cast(unsigned, f); return (u + 0x7fffu + ((u >> 16) & 1u)) >> 16; }
__device__ __forceinline__ unsigned pk2(float lo, float hi) { return f2bf(lo) | (f2bf(hi) << 16); }

#define XB_TMO      128
#define XB_XCNT(j)  (256  + 64 * (j))
#define XB_XSUB(j)  (1280 + 64 * (j))
#define XB_XGEN(j)  (2304 + 64 * (j))
#define XB_TOP      3328
#define XB_TOPGEN   3392
#define XCD_BAR_WORDS 3456
#define XB_SPIN_CAP (1u << 18)

__device__ __forceinline__ unsigned xb_ld(unsigned* p)              { return __hip_atomic_load(p, __ATOMIC_RELAXED, __HIP_MEMORY_SCOPE_AGENT); }
__device__ __forceinline__ unsigned xb_add(unsigned* p, unsigned v) { return __hip_atomic_fetch_add(p, v, __ATOMIC_RELAXED, __HIP_MEMORY_SCOPE_AGENT); }
__device__ __forceinline__ unsigned xb_xcc_id() { return (unsigned)__builtin_amdgcn_s_getreg((3 << 11) | 20) & 0xFu; }
#define XB_SPIN(cond, bar) do { unsigned _sp = 0; while (cond) { __builtin_amdgcn_s_sleep(1); \
    if ((++_sp & 255u) == 0u) { if (xb_ld(&(bar)[XB_TMO])) break; if (_sp > XB_SPIN_CAP) { atomicAdd(&(bar)[XB_TMO], 1u); break; } } } } while (0)

struct XcdBarrier {
    unsigned* bar; unsigned x;
    volatile LAS unsigned* st;
};

__device__ __forceinline__ XcdBarrier xcd_barrier_post(unsigned* bar, volatile LAS unsigned* st) {
    XcdBarrier b; b.bar = bar; b.x = xb_xcc_id(); b.st = st;
    if (threadIdx.x == 0) (void)xb_add(&bar[XB_XCNT(b.x)], 1u);
    return b;
}
__device__ __forceinline__ void xcd_barrier_complete(unsigned* bar, unsigned x, unsigned& nloc, unsigned& nx) {
    const unsigned G = gridDim.x * gridDim.y * gridDim.z;
    unsigned sum, cnt, mine, sp = 0u;
    for (;;) {
        sum = 0u; cnt = 0u; mine = 0u;
#pragma unroll
        for (unsigned j = 0; j < 16; ++j) { const unsigned c = xb_ld(&bar[XB_XCNT(j)]); sum += c; cnt += (c > 0u) ? 1u : 0u; mine = (j == x) ? c : mine; }
        if (sum == G) break;
        __builtin_amdgcn_s_sleep(1);
        if ((++sp & 255u) == 0u) { if (xb_ld(&bar[XB_TMO])) break; if (sp > XB_SPIN_CAP) { atomicAdd(&bar[XB_TMO], 1u); break; } }
    }
    nloc = mine > 0u ? mine : 1u; nx = cnt > 0u ? cnt : 1u;
}

__device__ __forceinline__ void xcd_barrier(const XcdBarrier& b) {
    asm volatile("s_waitcnt vmcnt(0)" ::: "memory");
    __syncthreads();
    if (threadIdx.x == 0) {
        unsigned* bar = b.bar;
        __builtin_amdgcn_s_waitcnt(0);
        unsigned nloc = b.st[0], nx = b.st[1];
        if (nloc == 0u) { xcd_barrier_complete(bar, b.x, nloc, nx); b.st[0] = nloc; b.st[1] = nx; }
        const unsigned old = xb_add(&bar[XB_XSUB(b.x)], 1u);
        const unsigned gen = old / nloc;
        if (old + 1u == (gen + 1u) * nloc) {
            __builtin_amdgcn_fence(__ATOMIC_RELEASE, "agent");
            asm volatile("s_waitcnt vmcnt(0)" ::: "memory");
            const unsigned og = xb_add(&bar[XB_TOP], 1u);
            const unsigned tg = og / nx;
            if (og + 1u == (tg + 1u) * nx) xb_add(&bar[XB_TOPGEN], 1u);
            else XB_SPIN(xb_ld(&bar[XB_TOPGEN]) == tg, bar);
            __builtin_amdgcn_fence(__ATOMIC_ACQUIRE, "agent");
            xb_add(&bar[XB_XGEN(b.x)], 1u);
            asm volatile("s_waitcnt vmcnt(0)" ::: "memory");
        } else {
            XB_SPIN(xb_ld(&bar[XB_XGEN(b.x)]) == gen, bar);
            __builtin_amdgcn_fence(__ATOMIC_ACQUIRE, "agent");
            asm volatile("s_waitcnt vmcnt(0)" ::: "memory");
        }
    }
    __syncthreads();
}
constexpr int NWAVES = 8;
constexpr int D = 1024, MROWS = pg8::MROWS, MP = pg8::MP, SEQ_T = 8192, NB = 4, NCH = 128, DFF = 2816, NIN = 6656, NGU = 5632;
constexpr int DEC_B = 16, DEC_T = 16, CACHE_L = 128;
constexpr size_t MiB = 1u << 20;
constexpr size_t WS_CTL = 0, CTL_ZERO_BYTES = 64 * 1024;
constexpr size_t WS_SS = 2 * MiB, WS_CK = 5 * MiB, WS_CV = 6 * MiB;
constexpr size_t WS_WIN = 8 * MiB, WS_WOUT = 21 * MiB, WS_WGU = 23 * MiB, WS_WD = 34 * MiB;
constexpr size_t WS_XN = 40 * MiB;
constexpr size_t WS_Q = 105 * MiB;
constexpr size_t WS_K = 170 * MiB, WS_V = 187 * MiB;
constexpr size_t WS_U = 204 * MiB, WS_BG = 269 * MiB, WS_SG = 334 * MiB;
constexpr size_t WS_H = 204 * MiB;
constexpr size_t WS_HS = 399 * MiB;
constexpr size_t WS_MGS = 401 * MiB;
constexpr size_t WS_MG = 402 * MiB;
constexpr size_t WS_IR = 467 * MiB;
constexpr size_t WS_END = 468 * MiB;
static_assert(WS_SS + (size_t)MROWS * 16 * 4 <= WS_CK && WS_WIN + (size_t)NIN * D * 2 <= WS_WOUT && WS_WGU + (size_t)NGU * D * 2 <= WS_WD && WS_WD + (size_t)D * DFF * 2 <= WS_XN, "ws map 1");
static_assert(WS_XN + (size_t)MROWS * D * 2 <= WS_Q && WS_Q + (size_t)MROWS * D * 2 <= WS_K && WS_K + (size_t)(MROWS + 64) * 256 * 2 <= WS_V && WS_V + (size_t)(MROWS + 64) * 256 * 2 <= WS_U, "ws map 2");
static_assert(WS_U + (size_t)MROWS * D * 2 <= WS_BG && WS_BG + (size_t)MROWS * D * 2 <= WS_SG && WS_SG + (size_t)MROWS * D * 2 <= WS_HS && WS_H + (size_t)MROWS * DFF * 2 <= WS_HS && WS_HS + (size_t)256 * DFF * 2 <= WS_MGS && WS_MGS + (size_t)256 * D * 2 <= WS_MG && WS_MG + (size_t)MROWS * D * 2 <= WS_IR && WS_IR + (size_t)MROWS * 4 <= WS_END, "ws map 3");
static_assert(WS_Q == pg8::EO_Q && WS_K == pg8::EO_K && WS_V == pg8::EO_V && WS_U == pg8::EO_U && WS_BG == pg8::EO_BG && WS_SG == pg8::EO_SG, "epilogue offsets");
constexpr int CW_TMO = 0, CW_CODE = 1, CW_BAR = 4096;
static_assert((CW_BAR + 3456) * 4 <= (int)CTL_ZERO_BYTES, "control words inside the per-call memset");

constexpr int RING_OFF = 0, RING_BYTES = 131072;
constexpr int LDSCTL_OFF = 139264, MISC_OFF = LDSCTL_OFF + 320;
constexpr int LDS_BYTES = 147456;

struct Frame {
    LAS unsigned char* lds;
    volatile LAS unsigned* MISC;
    gu32* ctl;
    int tid, lane, wave;
    int vcu, G;
    const float *xp, *xs, *state_conv, *cache_k, *cache_v, *norm_mix_w, *w_in, *conv_w, *q_norm_w, *k_norm_w, *sinks, *w_out, *norm_ffn_w, *w_gate, *w_up, *w_down;
    float* out;
    bf16 *Win_t, *Wout_t, *Wgu_t, *Wd_t;
    bf16 *XN, *MG, *Q, *X1B, *KB, *VB, *U, *BG, *SG, *H, *CK, *CV;
    float* SS; float* IR;
};

#ifndef NT_P0
#define NT_P0 1
#endif
#ifndef NT_MRG
#define NT_MRG 1
#endif
#ifndef NT_Q
#define NT_Q 0
#endif
#define NT_IF(c, p) ((c) ? __builtin_nontemporal_load(p) : *(p))
#if NT_P0
#define NT_LOAD(p) __builtin_nontemporal_load(p)
#else
#define NT_LOAD(p) (*(p))
#endif
__device__ __forceinline__ float wave_sum(float v) {
#pragma unroll
    for (int o = 1; o < 64; o <<= 1) v += __shfl_xor(v, o);
    return v;
}
struct WItem { const float* W; bf16* WT; const float* sc; int K, N, k0, n0, drow0; };
__device__ __forceinline__ void p0_item_load(const WItem& w, f32x4 (&t)[8], int lane) {
#pragma unroll
    for (int i = 0; i < 8; ++i) t[i] = NT_LOAD((const GAS f32x4*)(w.W + (size_t)(w.k0 + 8 * i + (lane >> 3)) * w.N + w.n0 + 4 * (lane & 7)));
}
__device__ __forceinline__ void p0_item_finish(const WItem& w, const f32x4 (&t)[8], LAS float* scr, int lane) {
#pragma unroll
    for (int i = 0; i < 8; ++i) { const int kk = 8 * i + (lane >> 3); f32x4 v = t[i]; if (w.sc) v = v * w.sc[w.k0 + kk]; LAS float* d = scr + kk * 33 + 4 * (lane & 7); d[0] = v.x; d[1] = v.y; d[2] = v.z; d[3] = v.w; }
    LDS_WAIT(); asm volatile("" ::: "memory");
    const int c = lane & 7;
#pragma unroll
    for (int j = 0; j < 4; ++j) { const int n = (lane >> 3) + 8 * j; const LAS float* s = scr + (8 * c) * 33 + n;
        v4u o; o.x = pk2(s[0 * 33], s[1 * 33]); o.y = pk2(s[2 * 33], s[3 * 33]); o.z = pk2(s[4 * 33], s[5 * 33]); o.w = pk2(s[6 * 33], s[7 * 33]);
        *(GAS v4u*)(w.WT + (size_t)(w.drow0 + n) * w.K + w.k0 + 8 * c) = o; }
    LDS_WAIT(); asm volatile("" ::: "memory");
}
__device__ __forceinline__ int win_dest_row(int n) {
    if (n < 1024) return 256 * (n >> 7) + (n & 127);
    if (n < 2048) { const int q = n - 1024; return 256 * (8 + (q >> 7)) + (q & 127); }
    if (n < 3072) { const int q = n - 2048; return 256 * (q >> 7) + 128 + (q & 127); }
    if (n < 4608) { const int q = n - 3072; const int t = q >> 8, r = q & 255;
                    return 256 * (16 + t) + 128 * ((r >> 5) & 1) + 32 * (r >> 6) + (r & 31); }
    if (n < 5632) { const int q = n - 4608; return 256 * (8 + (q >> 7)) + 128 + (q & 127); }
    return 256 * 22 + (n - 5632);
}
__device__ __forceinline__ void rms_row_to_bf16(Frame& F, const float* xrow, const float* w, bf16* orow) {
    const GAS f32x4* xr = (const GAS f32x4*)xrow + F.lane; const GAS f32x4* wr = (const GAS f32x4*)w + F.lane;
    f32x4 v[4]; float s2 = 0.f;
#pragma unroll
    for (int j = 0; j < 4; ++j) { v[j] = xr[64 * j]; s2 += (v[j].x * v[j].x + v[j].y * v[j].y) + (v[j].z * v[j].z + v[j].w * v[j].w); }
    const float rstd = __builtin_amdgcn_rsqf(wave_sum(s2) * (1.f / D) + pg8::RMS_EPS);
    GAS unsigned long long* o8 = (GAS unsigned long long*)orow + F.lane;
#pragma unroll
    for (int j = 0; j < 4; ++j) { const f32x4 ww = wr[64 * j]; o8[64 * j] = (unsigned long long)pk2(v[j].x * rstd * ww.x, v[j].y * rstd * ww.y) | ((unsigned long long)pk2(v[j].z * rstd * ww.z, v[j].w * rstd * ww.w) << 32); }
}
constexpr int I_IN = (D / 64) * (NIN / 32), I_O = (D / 64) * (D / 32), I_G = (D / 64) * (DFF / 32), I_D = (DFF / 64) * (D / 32);
__device__ __forceinline__ void p0_item_decode(Frame& F, int it, WItem& w) {
    int r = it; w.sc = nullptr;
    if (r < I_IN) { const int nblk = NIN / 32, kb = r / nblk, nb = r % nblk; w.W = F.w_in; w.K = D; w.N = NIN; w.WT = F.Win_t; w.k0 = 64 * kb; w.n0 = 32 * nb; w.drow0 = win_dest_row(32 * nb); return; } r -= I_IN;
    if (r < I_O) { const int nblk = D / 32, kb = r / nblk, nb = r % nblk; w.W = F.w_out; w.K = D; w.N = D; w.WT = F.Wout_t; w.k0 = 64 * kb; w.n0 = 32 * nb; w.drow0 = 32 * nb; return; } r -= I_O;
    if (r < 2 * I_G) { const int up = r >= I_G; if (up) r -= I_G; const int nblk = DFF / 32, kb = r / nblk, nb = r % nblk, n0 = 32 * nb;
        w.W = up ? F.w_up : F.w_gate; w.K = D; w.N = DFF; w.WT = F.Wgu_t; w.k0 = 64 * kb; w.n0 = n0; w.drow0 = 256 * (n0 >> 7) + 128 * up + (n0 & 127); w.sc = F.norm_ffn_w; return; } r -= 2 * I_G;
    { const int nblk = D / 32, kb = r / nblk, nb = r % nblk; w.W = F.w_down; w.K = DFF; w.N = D; w.WT = F.Wd_t; w.k0 = 64 * kb; w.n0 = 32 * nb; w.drow0 = 32 * nb; }
}
__device__ __forceinline__ void p0_weight_range(Frame& F, int first, int count, int start, int step) {
    LAS float* scr = (LAS float*)(F.lds + RING_OFF + F.wave * 16384);
    int it = start; if (it >= count) return;
    WItem A, B; f32x4 ta[8], tb[8];
    p0_item_decode(F, first + it, A); p0_item_load(A, ta, F.lane);
    for (;;) {
        const int itn = it + step; const bool hn = itn < count;
        if (hn) { p0_item_decode(F, first + itn, B); p0_item_load(B, tb, F.lane); }
        p0_item_finish(A, ta, scr, F.lane);
        if (!hn) break;
        it = itn + step; const bool hn2 = it < count;
        if (hn2) { p0_item_decode(F, first + it, A); p0_item_load(A, ta, F.lane); }
        p0_item_finish(B, tb, scr, F.lane);
        if (!hn2) break;
    }
}
__device__ __forceinline__ void p0_weight_items(Frame& F, int first, int count, int w, int nw) { p0_weight_range(F, first, count, w * NWAVES + F.wave, nw * NWAVES); }
__device__ __forceinline__ void p0_prologue(Frame& F, bool defer_w) {
    LAS float* scr = (LAS float*)(F.lds + RING_OFF + F.wave * 16384);
    const int gw = F.vcu * NWAVES + F.wave, NGW = F.G * NWAVES;
    const int NITEMS = defer_w ? I_IN : I_IN + I_O + 2 * I_G + I_D;
    f32x4 nw[4];
#pragma unroll
    for (int j = 0; j < 4; ++j) nw[j] = ((const GAS f32x4*)F.norm_mix_w)[F.lane + 64 * j];
#define P0_LOADG(V, M0) do { _Pragma("unroll") for (int r = 0; r < 4; ++r) { const int m = (M0) + r * NGW; if (m < MROWS) { \
        const GAS f32x4* xr = (const GAS f32x4*)(m < MP ? F.xp + (size_t)m * D : F.xs + (size_t)(m - MP) * D) + F.lane; \
        _Pragma("unroll") for (int j = 0; j < 4; ++j) V[r][j] = NT_LOAD(xr + 64 * j); } } } while (0)
#define P0_DOG(V, M0) do { _Pragma("unroll") for (int r = 0; r < 4; ++r) { const int m = (M0) + r * NGW; if (m < MROWS) { \
        float s2 = 0.f; \
        _Pragma("unroll") for (int j = 0; j < 4; ++j) s2 += (V[r][j].x * V[r][j].x + V[r][j].y * V[r][j].y) + (V[r][j].z * V[r][j].z + V[r][j].w * V[r][j].w); \
        const float ms = wave_sum(s2) * (1.f / D) + pg8::RMS_EPS; const float rstd = __builtin_amdgcn_rsqf(ms); \
        if (F.lane == 0) F.IR[m] = __builtin_sqrtf(ms); \
        GAS unsigned long long* o8 = (GAS unsigned long long*)(F.XN + (size_t)m * D) + F.lane; \
        _Pragma("unroll") for (int j = 0; j < 4; ++j) o8[64 * j] = (unsigned long long)pk2(V[r][j].x * rstd * nw[j].x, V[r][j].y * rstd * nw[j].y) | ((unsigned long long)pk2(V[r][j].z * rstd * nw[j].z, V[r][j].w * rstd * nw[j].w) << 32); } } } while (0)
    f32x4 va[4][4], vb[4][4];
    P0_LOADG(va, gw);
    p0_weight_range(F, 0, NITEMS, gw, NGW);
    for (int m0 = gw; m0 < MROWS; m0 += 8 * NGW) {
        P0_LOADG(vb, m0 + 4 * NGW); P0_DOG(va, m0);
        P0_LOADG(va, m0 + 8 * NGW); P0_DOG(vb, m0 + 4 * NGW);
    }
#undef P0_LOADG
#undef P0_DOG
    { const int gt = gw * 64 + F.lane, NT = NGW * 64;
      for (int i = gt; i < DEC_B * CACHE_L * 256 / 4; i += NT) {
          const f32x4 a = ((const GAS f32x4*)F.cache_k)[i], b = ((const GAS f32x4*)F.cache_v)[i];
          ((GAS unsigned long long*)F.CK)[i] = (unsigned long long)pk2(a.x, a.y) | ((unsigned long long)pk2(a.z, a.w) << 32);
          ((GAS unsigned long long*)F.CV)[i] = (unsigned long long)pk2(b.x, b.y) | ((unsigned long long)pk2(b.z, b.w) << 32); }
      for (int i = gt; i < 64 * 256 / 4; i += NT) { ((GAS unsigned long long*)(F.KB + (size_t)MROWS * 256))[i] = 0ull; ((GAS unsigned long long*)(F.VB + (size_t)MROWS * 256))[i] = 0ull; } }
}

namespace p2 {
using bf16x8 = __attribute__((ext_vector_type(8))) short;
using s16x4 = __attribute__((ext_vector_type(4))) short;
using f32x16 = __attribute__((ext_vector_type(16))) float;
typedef short v4i16_t __attribute__((ext_vector_type(4)));
typedef LAS const char* lds_cptr;
constexpr int LDS_K = 0, LDS_V = 3 * 8192, LDS_WS = 6 * 8192, LDS_OST = LDS_WS + 8 * 256, LDS_TOTAL = LDS_OST + 8 * 4096;
__device__ __forceinline__ int crow(int r, int hi) { return (r & 3) + 8 * (r >> 2) + 4 * hi; }
__device__ __forceinline__ s16x4 vtr(lds_cptr p) { return __builtin_bit_cast(s16x4, __builtin_amdgcn_ds_read_tr16_b64_v4i16((LAS v4i16_t*)p)); }
__device__ __forceinline__ unsigned cvtpk(float lo, float hi) { return pg8::cvt_pk_bf16(lo, hi); }
__device__ __forceinline__ float bf_lo(unsigned w) { return __uint_as_float(w << 16); }
__device__ __forceinline__ float bf_hi(unsigned w) { return __uint_as_float(w & 0xffff0000u); }

#ifdef P2_TS
#define P2TS_PARAM , unsigned long long p2ts_c
#define P2TS_ARG , p2ts_c
#else
#define P2TS_PARAM
#define P2TS_ARG
#endif
struct UnitDesc { const bf16* kt[3]; const bf16* vt[3]; int nv[3]; int row0; int g; int sample; int t0; };
constexpr int SET_BYTES = 6 * 8192;
constexpr int OST_ROWB = 144, OST_WAVEB = 32 * OST_ROWB;
constexpr int LDS_WS2 = 2 * SET_BYTES, LDS_OST2 = LDS_WS2 + 8 * 256, LDS_TOTAL2 = LDS_OST2 + 8 * OST_WAVEB;
static_assert(LDS_TOTAL2 + 16 <= LDSCTL_OFF - RING_OFF, "attention phase LDS");

__device__ __forceinline__ void make_prompt_unit(Frame& F, int id, UnitDesc& ud) {
    const int bg = id >> 7, c = id & 127, b = bg >> 2, g = bg & 3;
    ud.g = g; ud.sample = 0; ud.row0 = b * SEQ_T + 64 * c; ud.t0 = 64 * c;
#pragma unroll
    for (int j = 0; j < 3; ++j) { const int cc = c - 2 + j; const int cl = cc < 0 ? 0 : cc; ud.nv[j] = cc < 0 ? 0 : 64;
        const size_t off = (size_t)(b * SEQ_T + 64 * cl) * 256 + 64 * g; ud.kt[j] = F.KB + off; ud.vt[j] = F.VB + off; }
}
__device__ __forceinline__ void make_sample_unit(Frame& F, int id, UnitDesc& ud) {
    const int bs = id >> 2, g = id & 3;
    ud.g = g; ud.sample = 1; ud.row0 = MP + DEC_T * bs; ud.t0 = 0;
    ud.nv[0] = 64; ud.nv[1] = 64; ud.nv[2] = DEC_T;
    const size_t o0 = (size_t)(bs * CACHE_L) * 256 + 64 * g, o2 = (size_t)(MP + DEC_T * bs) * 256 + 64 * g;
    ud.kt[0] = F.CK + o0; ud.vt[0] = F.CV + o0; ud.kt[1] = F.CK + o0 + 64 * 256; ud.vt[1] = F.CV + o0 + 64 * 256; ud.kt[2] = F.KB + o2; ud.vt[2] = F.VB + o2;
}
struct UnitList { int p0, np, s0, ns, sstride; };
__device__ __forceinline__ void make_unit(Frame& F, const UnitList& L, int i, UnitDesc& ud) { if (i < L.np) make_prompt_unit(F, L.p0 + i, ud); else make_sample_unit(F, L.s0 + (i - L.np) * L.sstride, ud); }

__device__ __forceinline__ void issue_kv(Frame& F, const UnitDesc& ud, int setoff) {
    const int lane = F.lane, wid = F.wave;
#pragma unroll
    for (int j = 0; j < 3; ++j) {
        __builtin_amdgcn_global_load_lds((const unsigned*)(ud.kt[j] + (size_t)lane * 256 + wid * 8), (LAS unsigned*)(F.lds + RING_OFF + setoff + j * 8192 + wid * 1024), 16, 0, 0);
        __builtin_amdgcn_global_load_lds((const unsigned*)(ud.vt[j] + (size_t)(16 * (wid & 3) + (lane >> 2)) * 256 + 32 * (wid >> 2) + 8 * (lane & 3)), (LAS unsigned*)(F.lds + RING_OFF + setoff + 3 * 8192 + j * 8192 + wid * 1024), 16, 0, 0);
    }
}
__device__ __forceinline__ const bf16* q_addr(Frame& F, const UnitDesc& ud) {
    const int lane = F.lane, r32 = lane & 31, hi = lane >> 5, hh = F.wave >> 1, half = F.wave & 1;
    int qtok = half * 32 + r32; if (ud.sample && qtok > 15) qtok = 15;
    return F.Q + (size_t)(ud.row0 + qtok) * D + 256 * ud.g + 64 * hh + 8 * hi;
}
__device__ __forceinline__ void load_q(const bf16* qp, bf16x8 (&qr)[4]) {
#pragma unroll
    for (int d0 = 0; d0 < 4; ++d0) qr[d0] = NT_IF(NT_Q, (const GAS bf16x8*)(qp + 16 * d0));
}
typedef unsigned v2u __attribute__((ext_vector_type(2)));
__device__ __forceinline__ void unpack8b(const v2u& w, float (&o)[8]) { o[0] = (float)(w.x & 0xffu); o[1] = (float)((w.x >> 8) & 0xffu); o[2] = (float)((w.x >> 16) & 0xffu); o[3] = (float)(w.x >> 24);
    o[4] = (float)(w.y & 0xffu); o[5] = (float)((w.y >> 8) & 0xffu); o[6] = (float)((w.y >> 16) & 0xffu); o[7] = (float)(w.y >> 24); }
__device__ __forceinline__ void unpack8(const v4u& w, float (&o)[8]) { o[0] = bf_lo(w.x); o[1] = bf_hi(w.x); o[2] = bf_lo(w.y); o[3] = bf_hi(w.y); o[4] = bf_lo(w.z); o[5] = bf_hi(w.z); o[6] = bf_lo(w.w); o[7] = bf_hi(w.w); }

template <int MODE = 0  >
__device__ __forceinline__ void compute_unit(Frame& F, const UnitDesc& ud, int setoff, const bf16x8 (&qr)[4], bf16* mgbase, const bf16* qnp, bf16x8 (&qn)[4] P2TS_PARAM) {
    int lane_ = F.lane; asm volatile("" : "+v"(lane_));
    const int lane = lane_, r32 = lane & 31, hi = lane >> 5, wid = F.wave, hh = wid >> 1, half = wid & 1;
    LAS unsigned char* lds = F.lds + RING_OFF;
    if (ud.sample && half) return;
    f32x16 o[2]; o[0] = f32x16{}; o[1] = f32x16{};
    f32x16 p[6];
    const lds_cptr kp0 = (lds_cptr)(lds + setoff) + hi * 1024 + r32 * 16;
#pragma unroll
    for (int blk = 0; blk < 6; ++blk) {
        f32x16 a = {};
#pragma unroll
        for (int d0 = 0; d0 < 4; ++d0) {
            const bf16x8 kf = *(const LAS bf16x8*)(kp0 + (blk >> 1) * 8192 + (blk & 1) * 512 + d0 * 2048);
            a = __builtin_amdgcn_mfma_f32_32x32x16_bf16(kf, qr[d0], a, 0, 0, 0);
        }
        p[blk] = a;
    }
#ifdef P2_TS
    unsigned long long tq0 = 0, tq1 = 0, tq2 = 0, tq3 = 0;
    { int tmp; asm volatile("v_readfirstlane_b32 %0, %1" : "=s"(tmp) : "v"(p[5][15])); asm volatile("" :: "s"(tmp)); tq0 = __builtin_amdgcn_s_memrealtime(); }
#endif
    const float sink2 = F.sinks[4 * ud.g + hh] * 1.4426950408889634f;
    float l = 0.f, sk = sink2;
    const bool allvalid = ud.nv[0] == 64 && ud.nv[1] == 64 && ud.nv[2] == 64;
    if (!(allvalid && !ud.sample && __builtin_amdgcn_readfirstlane(*(const LAS int*)(lds + LDS_TOTAL2)) != 0)) {
        float mx = sink2;
        if (allvalid) {
#pragma unroll
            for (int blk = 0; blk < 6; ++blk)
#pragma unroll
                for (int r = 0; r < 16; ++r) mx = fmaxf(mx, p[blk][r]);
        } else {
#pragma unroll
            for (int blk = 0; blk < 6; ++blk) {
                const int nvj = ud.nv[blk >> 1];
#pragma unroll
                for (int r = 0; r < 16; ++r) { const int kk = (blk & 1) * 32 + crow(r, hi); const float s = kk < nvj ? p[blk][r] : -1e30f; p[blk][r] = s; mx = fmaxf(mx, s); }
            }
        }
        { auto rr = __builtin_amdgcn_permlane32_swap(__float_as_uint(mx), __float_as_uint(mx), false, false); mx = fmaxf(__uint_as_float(rr[0]), __uint_as_float(rr[1])); }
#pragma unroll
        for (int blk = 0; blk < 6; ++blk)
#pragma unroll
            for (int r = 0; r < 16; ++r) p[blk][r] -= mx;
        sk -= mx;
    }
    { typedef float f32x2_t __attribute__((ext_vector_type(2))); f32x2_t l2 = {0.f, 0.f};
#pragma unroll
      for (int blk = 0; blk < 6; ++blk)
#pragma unroll
          for (int r = 0; r < 16; r += 2) { const float e0 = __builtin_amdgcn_exp2f(p[blk][r]), e1 = __builtin_amdgcn_exp2f(p[blk][r + 1]); p[blk][r] = e0; p[blk][r + 1] = e1; l2 += (f32x2_t){e0, e1}; }
      l = l2.x + l2.y; }
    { auto rr = __builtin_amdgcn_permlane32_swap(__float_as_uint(l), __float_as_uint(l), false, false); l = __uint_as_float(rr[0]) + __uint_as_float(rr[1]); }
    l += __builtin_amdgcn_exp2f(sk);
#ifdef P2_TS
    { int tmp; asm volatile("v_readfirstlane_b32 %0, %1" : "=s"(tmp) : "v"(l)); asm volatile("" :: "s"(tmp)); tq1 = __builtin_amdgcn_s_memrealtime(); }
#endif
    const int ch = lane & 7, rb = lane >> 3; const int colg = 256 * ud.g + 64 * hh + 8 * ch;
    int tok0 = half * 32 + 4 * rb;
    const bool lane_on = !ud.sample || rb < 4;
    if (!lane_on) tok0 = 12;
    const size_t rowb = (size_t)ud.row0 + tok0; const int tb = ud.t0 + tok0;
    v2u sgv[4]; v4u bgv[4], uv[6];
#pragma unroll
    for (int k = 0; k < 4; ++k) { sgv[k] = NT_IF(NT_MRG, (const GAS v2u*)((const unsigned char*)F.SG + (rowb + k) * D + colg)); bgv[k] = NT_IF(NT_MRG, (const GAS v4u*)(F.BG + (rowb + k) * D + colg)); }
#pragma unroll
    for (int j = 0; j < 6; ++j) { const int dj = (tb + j - 2 >= 0) ? j - 2 : 0; uv[j] = NT_IF(NT_MRG, (const GAS v4u*)(F.U + (size_t)((long)rowb + dj) * D + colg)); }
    const lds_cptr vp0 = (lds_cptr)(lds + setoff + 3 * 8192) + ((lane >> 4) & 1) * 32 + (lane & 3) * 8 + (4 * hi + ((lane & 15) >> 2)) * 64;
#pragma unroll
    for (int ks = 0; ks < 12; ++ks) {
        const int blk = ks >> 1, s8 = (ks & 1) * 8;
        v4u pw; pw.x = cvtpk(p[blk][s8 + 0], p[blk][s8 + 1]); pw.y = cvtpk(p[blk][s8 + 2], p[blk][s8 + 3]); pw.z = cvtpk(p[blk][s8 + 4], p[blk][s8 + 5]); pw.w = cvtpk(p[blk][s8 + 6], p[blk][s8 + 7]);
        const bf16x8 pa = __builtin_bit_cast(bf16x8, pw);
#pragma unroll
        for (int d0 = 0; d0 < 2; ++d0) {
            const lds_cptr vp = vp0 + (ks >> 2) * 8192 + d0 * 4096 + (ks & 3) * 1024;
            const s16x4 lo = vtr(vp), hi4 = vtr(vp + 512);
            const bf16x8 vf = (bf16x8){lo[0], lo[1], lo[2], lo[3], hi4[0], hi4[1], hi4[2], hi4[3]};
            o[d0] = __builtin_amdgcn_mfma_f32_32x32x16_bf16(vf, pa, o[d0], 0, 0, 0);
        }
    }
#ifdef P2_TS
    { int tmp; asm volatile("v_readfirstlane_b32 %0, %1" : "=s"(tmp) : "v"(o[1][15])); asm volatile("" :: "s"(tmp)); tq2 = __builtin_amdgcn_s_memrealtime(); }
#endif
    if (qnp) load_q(qnp, qn);
    LAS unsigned char* stg = (LAS unsigned char*)(lds + LDS_OST2) + wid * OST_WAVEB;
    { const float rl = __builtin_amdgcn_rcpf(l * 255.f);
#pragma unroll
      for (int d0 = 0; d0 < 2; ++d0)
#pragma unroll
          for (int g = 0; g < 4; ++g) {
              v2u w; w.x = cvtpk(o[d0][4 * g + 0] * rl, o[d0][4 * g + 1] * rl); w.y = cvtpk(o[d0][4 * g + 2] * rl, o[d0][4 * g + 3] * rl);
              *(LAS v2u*)(stg + r32 * OST_ROWB + (32 * d0 + 8 * g + 4 * hi) * 2) = w; } }
    asm volatile("s_waitcnt lgkmcnt(0)" ::: "memory");
#ifdef P2_TS
    tq3 = __builtin_amdgcn_s_memrealtime();
#endif
    f32x4 cw[3][2];
#pragma unroll
    for (int k = 0; k < 3; ++k) { cw[k][0] = *(const GAS f32x4*)(F.conv_w + k * D + colg); cw[k][1] = *(const GAS f32x4*)(F.conv_w + k * D + colg + 4); }
    float uf[6][8];
#pragma unroll
    for (int j = 0; j < 6; ++j) unpack8(uv[j], uf[j]);
    if (tb < 2) {
        if (ud.sample) { const float* sp = F.state_conv + (size_t)((ud.row0 - MP) / DEC_T * 2) * D + colg;
#pragma unroll
            for (int j = 0; j < 2; ++j) if (tb + j - 2 < 0) { const int pr = 2 + (tb + j - 2); const f32x4 a = *(const GAS f32x4*)(sp + (size_t)pr * D), b = *(const GAS f32x4*)(sp + (size_t)pr * D + 4);
                uf[j][0] = a.x; uf[j][1] = a.y; uf[j][2] = a.z; uf[j][3] = a.w; uf[j][4] = b.x; uf[j][5] = b.y; uf[j][6] = b.z; uf[j][7] = b.w; } }
        else {
#pragma unroll
            for (int j = 0; j < 2; ++j) if (tb + j - 2 < 0) {
#pragma unroll
                for (int e = 0; e < 8; ++e) uf[j][e] = 0.f; } }
    }
#pragma unroll
    for (int k = 0; k < 4; ++k) {
        const v4u ya = *(const LAS v4u*)(stg + (4 * rb + k) * OST_ROWB + ch * 16);
        float yv[8], sv[8], bv[8];
        unpack8(ya, yv); unpack8b(sgv[k], sv); unpack8(bgv[k], bv);
        float mo[8];
#pragma unroll
        for (int e = 0; e < 8; ++e) {
            const float conv = cw[0][e >> 2][e & 3] * uf[k][e] + cw[1][e >> 2][e & 3] * uf[k + 1][e] + cw[2][e >> 2][e & 3] * uf[k + 2][e];
            mo[e] = bv[e] * conv + sv[e] * yv[e];
        }
        v4u w; w.x = cvtpk(mo[0], mo[1]); w.y = cvtpk(mo[2], mo[3]); w.z = cvtpk(mo[4], mo[5]); w.w = cvtpk(mo[6], mo[7]);
        if (lane_on) *(GAS v4u*)(mgbase + (rowb + k) * D + colg) = w;
    }
#ifdef P2_TS
    if (threadIdx.x == 0 && !ud.sample) { const unsigned long long tq4 = __builtin_amdgcn_s_memrealtime(); unsigned long long* tp = (unsigned long long*)(F.ctl + 8192) + 2048;
        tp[2 * 256 + blockIdx.x] += tq0 - p2ts_c; tp[3 * 256 + blockIdx.x] += tq1 - tq0; tp[4 * 256 + blockIdx.x] += tq2 - tq1; tp[5 * 256 + blockIdx.x] += tq3 - tq2; tp[6 * 256 + blockIdx.x] += tq4 - tq3; }
#endif
}

template <int MODE = 0>
__device__ __forceinline__ void attn_phase(Frame& F, bool prompt, bool sample, int tix, int nteam, bf16* mgs, bf16* mgp) {
    constexpr int NPU = NB * 4 * NCH;
    UnitList L; L.p0 = 0; L.np = 0; L.s0 = tix; L.ns = 0; L.sstride = nteam;
    if (prompt) { const int per = (NPU + F.G - 1) / F.G; L.p0 = F.vcu * per; L.np = NPU - L.p0 < per ? (NPU - L.p0 > 0 ? NPU - L.p0 : 0) : per;
        if (F.G == 256) { const int x = (int)blockIdx.x & 7, j = (int)blockIdx.x >> 3; L.p0 = (((x >> 1) * 4 + (j & 3)) * NCH) + 64 * (x & 1) + 8 * (j >> 2); L.np = 8; } }
    if (sample && tix < DEC_B * 4) L.ns = (DEC_B * 4 - tix + nteam - 1) / nteam;
    const int n = L.np + L.ns; if (n == 0) return;
    if (F.wave == 0) { float a = fabsf(F.q_norm_w[F.lane]), b = fabsf(F.k_norm_w[F.lane]), c = fabsf(F.sinks[F.lane & 15]) * 1.4426950408889634f;
#pragma unroll
      for (int o = 1; o < 64; o <<= 1) { a = fmaxf(a, __shfl_xor(a, o)); b = fmaxf(b, __shfl_xor(b, o)); c = fmaxf(c, __shfl_xor(c, o)); }
      if (F.lane == 0) *(LAS int*)(F.lds + RING_OFF + LDS_TOTAL2) = (64.f * pg8::QSCALE * a * b * 1.02f <= 60.f && c <= 60.f) ? 1 : 0; }
    UnitDesc ud; bf16x8 qr[4], qn[4];
    make_unit(F, L, 0, ud); issue_kv(F, ud, 0); load_q(q_addr(F, ud), qr);
    for (int i = 0; i < n; ++i) {
#ifdef P2_TS
        const unsigned long long p2ts_a = __builtin_amdgcn_s_memrealtime();
#endif
        __syncthreads();
#ifdef P2_TS
        const unsigned long long p2ts_b = __builtin_amdgcn_s_memrealtime();
#endif
        const int setoff = (i & 1) * SET_BYTES;
        const bf16* qnp = nullptr;
        if (i + 1 < n) { make_unit(F, L, i + 1, ud); issue_kv(F, ud, SET_BYTES - setoff); qnp = q_addr(F, ud); }
        make_unit(F, L, i, ud);
#ifdef P2_TS
        const unsigned long long p2ts_c = __builtin_amdgcn_s_memrealtime();
        if (threadIdx.x == 0 && prompt) { unsigned long long* tp = (unsigned long long*)(F.ctl + 8192) + 2048; tp[0 * 256 + blockIdx.x] += p2ts_b - p2ts_a; tp[1 * 256 + blockIdx.x] += p2ts_c - p2ts_b; }
#endif
        compute_unit<MODE>(F, ud, setoff, qr, i < L.np ? mgp : mgs, qnp, qn P2TS_ARG);
#pragma unroll
        for (int d0 = 0; d0 < 4; ++d0) qr[d0] = qn[d0];
    }
    __syncthreads();
}
}


__device__ __forceinline__ void stage_signal(gu32* cnt) {
    asm volatile("s_waitcnt vmcnt(0)" ::: "memory"); __syncthreads();
    if (threadIdx.x == 0) { __builtin_amdgcn_fence(__ATOMIC_RELEASE, "agent"); asm volatile("s_waitcnt vmcnt(0)" ::: "memory"); __hip_atomic_fetch_add(cnt, 1u, RLX_AGENT); }
}
__device__ __forceinline__ void stage_wait(gu32* cnt, unsigned target) {
    if (threadIdx.x == 0) {
        unsigned sp = 0; while (__hip_atomic_load(cnt, RLX_AGENT) < target) { __builtin_amdgcn_s_sleep(2); if (++sp > (1u << 21)) break; }
        __builtin_amdgcn_fence(__ATOMIC_ACQUIRE, "agent"); asm volatile("s_waitcnt vmcnt(0)" ::: "memory");
    }
    __syncthreads();
}
__device__ __forceinline__ void group_barrier(gu32* cnt, unsigned target) {
    asm volatile("s_waitcnt vmcnt(0)" ::: "memory"); __syncthreads();
    if (threadIdx.x == 0) {
        __builtin_amdgcn_fence(__ATOMIC_RELEASE, "agent"); asm volatile("s_waitcnt vmcnt(0)" ::: "memory"); __hip_atomic_fetch_add(cnt, 1u, RLX_AGENT);
        unsigned sp = 0; while (__hip_atomic_load(cnt, RLX_AGENT) < target) { __builtin_amdgcn_s_sleep(1); if (++sp > (1u << 22)) break; }
        __builtin_amdgcn_fence(__ATOMIC_ACQUIRE, "agent"); asm volatile("s_waitcnt vmcnt(0)" ::: "memory");
    }
    __syncthreads();
}
constexpr int CW_GRP = 3584;
constexpr int TEAM = 32;
constexpr int CW_TEAM = 3072;
struct Args { const float* in[16]; float* out; unsigned char* ws; };
__global__ void __launch_bounds__(NWAVES * 64, 2) mk_fwd(Args args) {
    extern __shared__ __attribute__((aligned(16))) unsigned char lds[];
    Frame F;
    F.lds = (LAS unsigned char*)lds;
    F.MISC = (volatile LAS unsigned*)(F.lds + MISC_OFF);
    F.tid = threadIdx.x; F.lane = F.tid & 63; F.wave = __builtin_amdgcn_readfirstlane(F.tid >> 6);
    F.G = gridDim.x; { const int bx = blockIdx.x; F.vcu = (F.G % 8 == 0) ? (bx % 8) * (F.G / 8) + bx / 8 : bx; }
    unsigned char* ws = args.ws;
    F.ctl = (gu32*)(ws + WS_CTL);
    F.xp = args.in[0]; F.xs = args.in[1]; F.state_conv = args.in[2]; F.cache_k = args.in[3]; F.cache_v = args.in[4]; F.norm_mix_w = args.in[5]; F.w_in = args.in[6]; F.conv_w = args.in[7];
    F.q_norm_w = args.in[8]; F.k_norm_w = args.in[9]; F.sinks = args.in[10]; F.w_out = args.in[11]; F.norm_ffn_w = args.in[12]; F.w_gate = args.in[13]; F.w_up = args.in[14]; F.w_down = args.in[15];
    F.out = args.out;
    F.Win_t = (bf16*)(ws + WS_WIN); F.Wout_t = (bf16*)(ws + WS_WOUT); F.Wgu_t = (bf16*)(ws + WS_WGU); F.Wd_t = (bf16*)(ws + WS_WD);
    F.XN = (bf16*)(ws + WS_XN);
    F.MG = (bf16*)(ws + WS_MG);
    F.Q = (bf16*)(ws + WS_Q); F.X1B = (bf16*)(ws + WS_Q); F.KB = (bf16*)(ws + WS_K); F.VB = (bf16*)(ws + WS_V);
    F.U = (bf16*)(ws + WS_U); F.BG = (bf16*)(ws + WS_BG); F.SG = (bf16*)(ws + WS_SG); F.H = (bf16*)(ws + WS_H); F.CK = (bf16*)(ws + WS_CK); F.CV = (bf16*)(ws + WS_CV);
    F.SS = (float*)(ws + WS_SS); F.IR = (float*)(ws + WS_IR);
    for (int u = F.tid; u < (LDS_BYTES - LDSCTL_OFF) / 4; u += NWAVES * 64) ((LAS unsigned*)(F.lds + LDSCTL_OFF))[u] = 0u;
    __syncthreads();
    XcdBarrier bar; bar.bar = (unsigned*)(F.ctl + CW_BAR); bar.x = 0; bar.st = nullptr;
    bar = xcd_barrier_post((unsigned*)(F.ctl + CW_BAR), F.MISC + 8);
#define GRID_BAR() xcd_barrier(bar)

#ifndef DEFER_W
#define DEFER_W 1
#endif
#ifdef TSPROBE
    if (threadIdx.x == 0) ((volatile unsigned long long*)(F.ctl + 8192))[3840 + blockIdx.x] = rt();
#endif
    p0_prologue(F, DEFER_W && gridDim.x == 256);
#ifdef TSPROBE
    if (threadIdx.x == 0) ((volatile unsigned long long*)(F.ctl + 8192))[0 * 256 + blockIdx.x] = rt();
#endif
    GRID_BAR();
    const int tix = (int)blockIdx.x; const bool use_team = (F.G == 256); const bool team = use_team && tix < TEAM;
#ifdef TSPROBE
#define TS(k) do { if (threadIdx.x == 0) ((volatile unsigned long long*)(F.ctl + 8192))[(k) * 256 + tix] = rt(); } while (0)
#else
#define TS(k) do {} while (0)
#endif
    const int MPR = use_team ? MP : MROWS;
    bf16* const Hs = (bf16*)(ws + WS_HS) - (size_t)MP * DFF;
    bf16* const MGs = (bf16*)(ws + WS_MGS) - (size_t)MP * D;
#ifdef EPI_TS
#define EPI_TS_INIT , (unsigned long long*)(F.ctl + 8192)
#else
#define EPI_TS_INIT
#endif
#define RUN_IN(S_)  do { pg8::Gemm g{F.XN, F.Win_t, MROWS, NIN, D}; pg8::EpiIn E{ws, F.q_norm_w, F.k_norm_w, F.out}; pg8::gemm_phase<pg8::EpiIn, pg8::Order, KN_ALIGN, KN_SP2>(F.lds + RING_OFF, g, S_, E); } while (0)
#define RUN_OUT(S_, MG_) do { pg8::Gemm g{MG_, F.Wout_t, MROWS, D, D}; pg8::EpiOut E{F.XN, F.IR, F.norm_mix_w, F.X1B, F.SS, (PG8_LAS float*)(F.lds + RING_BYTES)}; pg8::gemm_phase<pg8::EpiOut, pg8::Order, KN_ALIGN, KN_SP2, AUX_OUT>(F.lds + RING_OFF, g, S_, E); } while (0)
#define RUN_GU(S_, H_) RUN_GU_M(S_, H_, -1, -1)
#define RUN_GU_M(S_, H_, AM_, BM_)   do { pg8::Gemm g{F.X1B, F.Wgu_t, MROWS, NGU, D, AM_, BM_}; pg8::EpiGU E{F.SS, H_}; pg8::gemm_phase<pg8::EpiGU, pg8::Order, KN_ALIGN_GU, KN_SP2>(F.lds + RING_OFF, g, S_, E); } while (0)
#define RUN_DOWN(S_, H_) do { pg8::Gemm g{H_, F.Wd_t, MROWS, D, DFF}; pg8::EpiDown E{F.out + pg8::OUT_Y, F.X1B EPI_TS_INIT}; pg8::gemm_phase<pg8::EpiDown, pg8::Order, KN_ALIGN_DN, KN_SP2, AUX_DN>(F.lds + RING_OFF, g, S_, E); } while (0)
#ifndef KN_ALIGN
#define KN_ALIGN true
#endif
#ifndef KN_ALIGN_GU
#define KN_ALIGN_GU KN_ALIGN
#endif
#ifndef KN_ALIGN_DN
#define KN_ALIGN_DN KN_ALIGN
#endif
#ifndef AUX_DN
#define AUX_DN 0
#endif
#ifndef AUX_OUT
#define AUX_OUT 0
#endif
#ifndef KN_SP2
#define KN_SP2 true
#endif
#ifndef REV_DOWN
#define REV_DOWN 1
#endif
#define TEAM_CHAIN() do { gu32* const c1 = F.ctl + CW_TEAM, * const c2 = c1 + 64, * const c3 = c1 + 128, * const c4 = c1 + 192, * const w1 = c1 + 256, * const w2 = c1 + 320; pg8::Order S; \
          \
        if (tix < 26) { S.panel(128, NIN, tix, TEAM); RUN_IN(S); stage_signal(c1); } \
        else { if (DEFER_W) p0_weight_items(F, I_IN, I_O, tix - 26, TEAM - 26); stage_signal(w1); } \
        stage_wait(c1, 26); p2::attn_phase(F, false, true, tix, TEAM, MGs, F.MG); stage_signal(c2); \
        if (tix < 4) { stage_wait(c2, TEAM); stage_wait(w1, TEAM - 26); S.panel(128, D, tix, TEAM); RUN_OUT(S, MGs); stage_signal(c3); } \
        else if (tix < 24 || tix >= 28) { if (DEFER_W) p0_weight_items(F, I_IN + I_O, 2 * I_G + I_D, tix < 24 ? tix - 4 : tix - 8, TEAM - 8); stage_signal(w2); }     \
        if (tix < 22) { stage_wait(c3, 4); stage_wait(w2, TEAM - 8); S.panel(128, NGU, tix, TEAM); RUN_GU(S, Hs); stage_signal(c4); } \
        if (tix < 4) { stage_wait(c4, 22); S.panel(128, D, tix, TEAM); RUN_DOWN(S, Hs); } } while (0)
#define PROMPT_IN() do { pg8::Order S; \
        if (!use_team) S.grid(MROWS, NIN, tix, F.G, 1 << 30); \
        else if (team) {   \
            const int r = tix & 7, q = tix >> 3; const bool heavy = r < 4; \
            const int share = heavy ? (q == 0 ? 2 : (q == 3 ? 10 : 6)) : 6, first = heavy ? (q == 0 ? 0 : (q == 1 ? 2 : (q == 2 ? 8 : 14))) : 6 * q; \
            S.grid(MP, NIN, (F.G - TEAM) * 14 + r + 8 * first, 8, share); } \
        else S.grid(MP, NIN, tix - TEAM, F.G - TEAM, 14); \
        RUN_IN(S); } while (0)
    if (team) TEAM_CHAIN();
    PROMPT_IN();                                         TS(1); GRID_BAR();
#define GROUP_BAR(n) do { if (use_team) group_barrier(F.ctl + CW_GRP + 64 * (tix & 7), 32u * (n)); else GRID_BAR(); } while (0)
    {
        pg8::Order S;
        p2::attn_phase(F, true, !use_team, tix, F.G, F.MG, F.MG);        TS(2); GRID_BAR();
#ifdef P2_EXTRA
        p2::attn_phase<P2_EXTRA>(F, true, false, tix, F.G, (bf16*)F.out, (bf16*)F.out);   GRID_BAR();
#endif
        S.grid(MPR, D, tix, F.G, 1 << 30);   RUN_OUT(S, F.MG);     TS(3); GRID_BAR();
#if defined(GU_EXTRA) && GU_EXTRA == 1
        S.grid(MPR, NGU, tix, F.G, 1 << 30); RUN_GU_M(S, F.H, 7, 3); GRID_BAR();
#elif defined(GU_EXTRA)
        S.grid(MPR, NGU, tix, F.G, 1 << 30); RUN_GU(S, F.H); GRID_BAR();
#endif
#ifdef TSPROBE
        unsigned long long ck0 = __builtin_readcyclecounter(), rk0 = rt();
#endif
        S.grid(MPR, NGU, tix, F.G, 1 << 30); RUN_GU(S, F.H); TS(4);
#ifdef TSPROBE
        { const unsigned long long ck1 = __builtin_readcyclecounter(), rk1 = rt(); if (threadIdx.x == 0) { volatile unsigned long long* cp = (volatile unsigned long long*)(F.ctl + 8192) + 7 * 256; cp[tix] = ((ck1 - ck0) * 1000ull) / (rk1 - rk0); } }
#endif
        GRID_BAR(); TS(6);
        S.grid(MPR, D, tix, F.G, 1 << 30, REV_DOWN);   RUN_DOWN(S, F.H);
#ifdef TSPROBE
        asm volatile("s_waitcnt vmcnt(0)" ::: "memory"); TS(5); GRID_BAR();
        if (tix == 0) {
            LAS float* sh = (LAS float*)(F.lds + RING_OFF);
            if (threadIdx.x == 0) {
                const volatile unsigned long long* ts = (const volatile unsigned long long*)(F.ctl + 8192);
                float mx[6], mn[6], av[6], mxt[6], mxn[6], avt[6];
                for (int k = 0; k < 6; ++k) { unsigned long long t0 = ts[k * 256]; unsigned long long lo = t0, hi = t0, hit = t0, hin = ts[k * 256 + 32]; double s = 0, st = 0;
                    for (int w = 0; w < 256; ++w) { const unsigned long long t = ts[k * 256 + w]; lo = t < lo ? t : lo; hi = t > hi ? t : hi; s += (double)(long long)(t - t0);
                        if (w < 32) { hit = t > hit ? t : hit; st += (double)(long long)(t - t0); } else hin = t > hin ? t : hin; }
                    const unsigned long long base = ts[0]; mx[k] = (float)(long long)(hi - base) * 0.01f; mn[k] = (float)(long long)(lo - base) * 0.01f; av[k] = ((float)(long long)(t0 - base) + (float)(s / 256.0)) * 0.01f;
                    mxt[k] = (float)(long long)(hit - base) * 0.01f; mxn[k] = (float)(long long)(hin - base) * 0.01f; avt[k] = ((float)(long long)(t0 - base) + (float)(st / 32.0)) * 0.01f; }
                float m = 0.f; const int sel = TSPROBE;
                if (sel < 6) m = mx[sel] - av[sel];
                else if (sel == 9) { for (int k = 0; k < 6; ++k) m += mx[k] - av[k]; }
                else if (sel >= 10 && sel < 16) m = mx[sel - 10] - mn[sel - 10];
                else if (sel >= 21 && sel < 26) m = mx[sel - 20] - mx[sel - 21];
                else if (sel >= 31 && sel < 36) m = av[sel - 30] - mx[sel - 31];
                else if (sel >= 40 && sel < 46) m = mxt[sel - 40] - av[sel - 40];
                else if (sel >= 50 && sel < 56) m = mxn[sel - 50] - av[sel - 50];
                else if (sel >= 60 && sel < 66) m = fabsf(avt[sel - 60] - av[sel - 60]);
                else if (sel >= 70 && sel < 76) m = av[sel - 70] - mn[sel - 70];
                else if (sel == 80 || sel == 81) { const unsigned long long base = ts[0]; float best = -1e30f;
                    for (int w = (sel == 81 ? 32 : 0); w < 256; ++w) { float s = 0.f; for (int k = 0; k < 6; ++k) if (k != 1 || sel == 81) s += (float)(long long)(ts[k * 256 + w] - base) * 0.01f - av[k]; best = fmaxf(best, s); }
                    m = best; }
                else if (sel == 98 || sel == 99) { const unsigned long long base = ts[0]; float best = -1e30f; int bx = 0;
                    for (int x = 0; x < 8; ++x) { float s = 0.f; for (int w = x; w < 256; w += 8) for (int k = 0; k < 6; ++k) if (k != 1) s += (float)(long long)(ts[k * 256 + w] - base) * 0.01f - av[k];
                        s *= (1.f / 32.f); if (s > best) { best = s; bx = x; } }
                    m = sel == 98 ? best : 10.f * (float)(bx + 1); }
                else if (sel >= 100 && sel < 104) { const volatile unsigned long long* ep = (const volatile unsigned long long*)(F.ctl + 8192) + 2048 + 256 * (sel - 100); double s = 0; for (int w = 0; w < 256; ++w) s += (double)ep[w]; m = (float)(s / 256.0) * 0.01f; }
                else if (sel >= 110 && sel < 114) { const volatile unsigned long long* tp = (const volatile unsigned long long*)(F.ctl + 8192) + 2048; const volatile unsigned long long* t6 = (const volatile unsigned long long*)(F.ctl + 8192) + 6 * 256; double s = 0;
                    for (int w = 0; w < 256; ++w) { const unsigned long long a0 = tp[1024 + w * 4], a1 = tp[1024 + w * 4 + 1], b0 = tp[1024 + w * 4 + 2], b1 = tp[1024 + w * 4 + 3];
                        s += sel == 110 ? (double)(long long)(a0 - t6[w]) : sel == 111 ? (double)(long long)(b0 - a1) : sel == 112 ? (double)(long long)(a1 - a0) : (double)(long long)(b1 - b0); }
                    m = (float)(s / 256.0) * 0.01f; }
                else if (sel == 120) { const volatile unsigned long long* cp = (const volatile unsigned long long*)(F.ctl + 8192) + 7 * 256; double s = 0; for (int w = 0; w < 256; ++w) s += (double)cp[w]; m = (float)(s / 256.0) * 0.01f; }
                else if (sel >= 130 && sel < 137) { const volatile unsigned long long* tp = (const volatile unsigned long long*)(F.ctl + 8192) + 2048 + 256 * (sel - 130); double s = 0; for (int w = 0; w < 256; ++w) s += (double)tp[w]; m = (float)(s / 256.0) * 0.01f; }
                else if (sel == 140) { unsigned long long lo = ts[3840]; for (int w = 1; w < 256; ++w) { const unsigned long long t = ts[3840 + w]; lo = t < lo ? t : lo; } m = mx[0] + (float)(long long)(ts[0] - lo) * 0.01f; }
                else if (sel >= 90 && sel < 98) { const unsigned long long base = ts[0]; float s = 0.f;
                    for (int w = sel - 90; w < 256; w += 8) for (int k = 0; k < 6; ++k) if (k != 1) s += (float)(long long)(ts[k * 256 + w] - base) * 0.01f - av[k];
                    m = fabsf(s) * (1.f / 32.f); }
                sh[0] = floorf(m + 0.5f);
            }
            __syncthreads();
            const float sc = 1.f + sh[0] * (1.f / TSDIV);
            for (int i = threadIdx.x; i < 256 * 1024; i += NWAVES * 64) F.out[(size_t)MP * D + i] *= sc;
        }
#endif
    }
}

extern "C" void kernel_launch(void* const* d_in, const int* in_sizes, int n_in, void* d_out, int out_size, void* d_ws, size_t ws_size, hipStream_t stream) {
    static int grid = 0;
    if (grid == 0) {
        if (n_in != 16 || in_sizes[0] != MP * D || (size_t)out_size != pg8::OUT_TOTAL || ws_size < WS_END) {
            fprintf(stderr, "kernel_launch: shape mismatch: n_in %d in0 %d out %d ws %zu (need %zu); nothing launched\n", n_in, n_in > 0 ? in_sizes[0] : -1, out_size, ws_size, (size_t)WS_END); grid = -1; return; }
        int dev = 0, cus = 0, per_cu = 0;
        if (hipGetDevice(&dev) != hipSuccess || hipDeviceGetAttribute(&cus, hipDeviceAttributeMultiprocessorCount, dev) != hipSuccess) { fprintf(stderr, "kernel_launch: device query failed\n"); grid = -1; return; }
        if (hipFuncSetAttribute((const void*)mk_fwd, hipFuncAttributeMaxDynamicSharedMemorySize, LDS_BYTES) != hipSuccess) { fprintf(stderr, "kernel_launch: hipFuncSetAttribute failed\n"); grid = -1; return; }
        if (hipOccupancyMaxActiveBlocksPerMultiprocessor(&per_cu, (const void*)mk_fwd, NWAVES * 64, LDS_BYTES) != hipSuccess || per_cu < 1) { fprintf(stderr, "kernel_launch: occupancy query reports %d blocks per CU\n", per_cu); (void)hipGetLastError(); per_cu = 1; }
        grid = cus;
        if (grid % 8 != 0) grid -= grid % 8;
    }
    if (grid < 0) return;
    if (hipMemsetAsync((char*)d_ws + WS_CTL, 0, CTL_ZERO_BYTES, stream) != hipSuccess) { fprintf(stderr, "kernel_launch: memset failed\n"); return; }
    Args a{};
    for (int i = 0; i < 16; ++i) a.in[i] = (const float*)d_in[i];
    a.out = (float*)d_out; a.ws = (unsigned char*)d_ws;
    hipLaunchKernelGGL(mk_fwd, dim3(grid), dim3(NWAVES * 64), LDS_BYTES, stream, a);
    const hipError_t le = hipPeekAtLastError();
    if (le != hipSuccess) fprintf(stderr, "kernel_launch: launch failed: %s\n", hipGetErrorName(le));
}
```

```cpp
#include <hip/hip_runtime.h>
#include <cstdio>
#include <cstdint>
namespace pg8 {
#define PG8_LAS __attribute__((address_space(3)))
typedef unsigned short bf16_t;
typedef short bf16x8 __attribute__((ext_vector_type(8)));
typedef float f32x4 __attribute__((ext_vector_type(4)));
typedef unsigned u32x4 __attribute__((ext_vector_type(4)));
constexpr int BM = 256, BK = 64, HALF = 128, HTB = HALF * BK * 2  , STAGE_BYTES = 8 * HTB, NXCD = 8, WGM = 8;

__host__ __device__ __forceinline__ int lds_byte(int r, int c) { const int st = (r >> 4) * 2 + (c >> 5), rr = r & 15, cc = c & 31, ob = rr * 64 + cc * 2; return st * 1024 + (ob ^ (((ob >> 9) & 1) << 5)); }
__host__ __device__ __forceinline__ void stage_rc(int b, int& R, int& C) { const int st = b / 1024, sb = b % 1024, swz = sb ^ (((sb >> 9) & 1) << 5); R = (st >> 1) * 16 + swz / 64; C = (st & 1) * 32 + (swz % 64) / 2; }
__host__ __device__ __forceinline__ int perm32(int rho) { const int n = rho >> 4, i = rho & 15; return 8 * (i >> 2) + 4 * n + (i & 3); }

struct Unit { int pm, pn; };
struct Gemm { const bf16_t* A; const bf16_t* Bt; int M, N, K; int amask = -1, bmask = -1; };

struct StaticOrder {
    int nM, nN, nwg, G, c;
    __host__ __device__ void init(int M, int N, int G_, int c_) { nM = M / BM; nN = N / BM; nwg = nM * nN; G = G_; c = c_; }
    __host__ __device__ bool next(int i, Unit& u) const {
        const long L = (long)i * G + c; if (L >= nwg) return false;
        int wgid = (int)L; { const int q = nwg / NXCD, r = nwg % NXCD, xcd = wgid % NXCD, off = wgid / NXCD; wgid = (xcd < r ? xcd * (q + 1) : r * (q + 1) + (xcd - r) * q) + off; }
        const int nig = WGM * nN, gid = wgid / nig, fm = gid * WGM, gsz = (nM - fm) < WGM ? (nM - fm) : WGM;
        u.pm = fm + ((wgid % nig) % gsz); u.pn = (wgid % nig) / gsz; return true;
    }
    __device__ __forceinline__ void a_ready(const Unit&) const {}
    __device__ __forceinline__ void done(const Unit&) const {}
};
struct Order {
    int nM, nN, nwg, L0, stride, count, mode, pm_fixed, rev;
    __device__ __forceinline__ void grid(int M, int N, int L0_, int stride_, int count_, int rev_ = 0) { nM = M / BM; nN = N / BM; nwg = nM * nN; L0 = L0_; stride = stride_; count = count_; mode = 0; pm_fixed = 0; rev = rev_; }
    __device__ __forceinline__ void panel(int pm, int N, int L0_, int stride_) { nM = 1; nN = N / BM; nwg = nN; L0 = L0_; stride = stride_; count = 1 << 30; mode = 1; pm_fixed = pm; rev = 0; }
    __device__ __forceinline__ bool next(int i, Unit& u) const {
        if (i >= count) return false;
        const long L = (long)i * stride + L0; if (L >= nwg) return false;
        if (mode == 1) { u.pm = pm_fixed; u.pn = (int)L; return true; }
        int wgid = (int)L; { const int q = nwg / NXCD, r = nwg % NXCD, xcd = wgid % NXCD, off = wgid / NXCD;
            const int clen = xcd < r ? q + 1 : q, cst = xcd < r ? xcd * (q + 1) : r * (q + 1) + (xcd - r) * q;
            wgid = cst + (rev ? clen - 1 - off : off); }
        const int nig = WGM * nN, gid = wgid / nig, fm = gid * WGM, gsz = (nM - fm) < WGM ? (nM - fm) : WGM;
        u.pm = fm + ((wgid % nig) % gsz); u.pn = (wgid % nig) / gsz; return true;
    }
    __device__ __forceinline__ void a_ready(const Unit&) const {}
    __device__ __forceinline__ void done(const Unit&) const {}
};

typedef float f32x2_t __attribute__((ext_vector_type(2))); typedef __bf16 bf16x2_t __attribute__((ext_vector_type(2)));
__device__ __forceinline__ unsigned cvt_pk_bf16(float lo, float hi) { f32x2_t v = {lo, hi}; bf16x2_t b = __builtin_convertvector(v, bf16x2_t); return __builtin_bit_cast(unsigned, b); }
__device__ __forceinline__ float sigmoid_f(float x) { return __builtin_amdgcn_rcpf(1.0f + __builtin_amdgcn_exp2f(-1.4426950408889634f * x)); }
__device__ __forceinline__ f32x4 sigmoid4(const f32x4& x) {
    const f32x4 t = x * -1.4426950408889634f; f32x4 e, s;
#pragma unroll
    for (int j = 0; j < 4; ++j) e[j] = __builtin_amdgcn_exp2f(t[j]);
    e = e + (f32x4){1.f, 1.f, 1.f, 1.f};
#pragma unroll
    for (int j = 0; j < 4; ++j) s[j] = __builtin_amdgcn_rcpf(e[j]);
    return s;
}
__device__ __forceinline__ f32x4 sigmoid255(const f32x4& x) {
    const f32x4 t = x * -1.4426950408889634f; f32x4 e, s;
#pragma unroll
    for (int j = 0; j < 4; ++j) e[j] = __builtin_amdgcn_exp2f(t[j]);
    e = e * (1.0f / 255.0f) + (f32x4){1.0f / 255.0f, 1.0f / 255.0f, 1.0f / 255.0f, 1.0f / 255.0f};
#pragma unroll
    for (int j = 0; j < 4; ++j) s[j] = __builtin_amdgcn_rcpf(e[j]);
    return s;
}
__device__ __forceinline__ u32x4 pack8(const f32x4& a, const f32x4& b) { u32x4 w; w.x = cvt_pk_bf16(a[0], a[1]); w.y = cvt_pk_bf16(a[2], a[3]); w.z = cvt_pk_bf16(b[0], b[1]); w.w = cvt_pk_bf16(b[2], b[3]); return w; }

constexpr int MROWS = 33024, MP = 32768, SEQ_T = 8192;
constexpr float RMS_EPS = 1e-6f;
constexpr size_t EO_Q = 105ull << 20, EO_K = 170ull << 20, EO_V = 187ull << 20, EO_U = 204ull << 20, EO_BG = 269ull << 20, EO_SG = 334ull << 20;
constexpr float QSCALE = 0.125f * 1.4426950408889634f;
constexpr size_t OUT_Y = 0, OUT_CONVP = 33816576, OUT_KP = 33824768, OUT_VP = 33955840, OUT_CONVS = 34086912, OUT_KS = 34119680, OUT_VS = 34185216, OUT_TOTAL = 34250752;

struct EpiIn {
    static constexpr bool PERM = true, AFTER_DRAIN = false;
    unsigned char* ws; const float *qw, *kw; float* out;
    struct Pre {}; __device__ __forceinline__ void prefetch(const Unit&, Pre&, int, int, int) const {}
    __device__ __forceinline__ void operator()(const f32x4 (&acc)[2][2][4][2], const Unit& u, int wr, int wc, int fr, int fq, const Pre&) const {
        asm volatile("" : "+v"(fr), "+v"(fq), "+s"(wr), "+s"(wc));
        const int pn = u.pn, pm = u.pm;
        bf16_t* const U = (bf16_t*)(ws + EO_U); bf16_t* const BG = (bf16_t*)(ws + EO_BG); bf16_t* const SG = (bf16_t*)(ws + EO_SG);
        bf16_t* const Q = (bf16_t*)(ws + EO_Q); bf16_t* const K = (bf16_t*)(ws + EO_K); bf16_t* const V = (bf16_t*)(ws + EO_V);
        const int lrow0 = wr * 64 + fr;
        const size_t grow0 = (size_t)pm * BM + lrow0;
        if (pn < 16) {
            const bool isU = pn < 8; const int p = isU ? pn : pn - 8;
            bf16_t* O = isU ? U : BG;
            const int col = 128 * p + 32 * wc + 8 * fq;
#pragma unroll
            for (int ai = 0; ai < 2; ++ai)
#pragma unroll
                for (int m = 0; m < 4; ++m) {
                    f32x4 a0 = acc[ai][0][m][0], a1 = acc[ai][0][m][1], b0 = acc[ai][1][m][0], b1 = acc[ai][1][m][1];
                    f32x4 r0, r1;
                    if (isU) { r0 = a0 * b0; r1 = a1 * b1; }
                    else {
#pragma unroll
                        for (int j = 0; j < 1; ++j) { r0 = a0 * sigmoid4(b0); r1 = a1 * sigmoid4(b1); }
                    }
                    const size_t row = grow0 + ai * HALF + m * 16;
                    *(u32x4*)(O + row * 1024 + col) = pack8(r0, r1);
                    if (isU && fr >= 14) {
                        float* dst = nullptr;
                        if (pm == 128) dst = out + OUT_CONVS + (size_t)((8 * ai + 4 * wr + m) * 2 + (fr - 14)) * 1024 + col;
                        else if ((pm & 31) == 31 && ai == 1 && wr == 1 && m == 3) dst = out + OUT_CONVP + (size_t)((pm >> 5) * 2 + (fr - 14)) * 1024 + col;
                        if (dst) { *(f32x4*)dst = r0; *(f32x4*)(dst + 4) = r1; }
                    }
                }
        } else if (pn < 22) {
            const bool isQ = pn < 20, isK = pn == 20;
            const float* nw = isQ ? qw : kw; asm volatile("" : "+s"(nw));
            f32x4 w[2][2];
#pragma unroll
            for (int bj = 0; bj < 2; ++bj)
#pragma unroll
                for (int n = 0; n < 2; ++n) {
                    if (pn == 21) w[bj][n] = (f32x4){1.f, 1.f, 1.f, 1.f};
                    else { w[bj][n] = *(const __attribute__((address_space(1))) f32x4*)(nw + 32 * bj + 8 * fq + 4 * n); if (isQ) w[bj][n] = w[bj][n] * QSCALE; }
                }
            bf16_t* O = isQ ? Q : (isK ? K : V); const int ldo = isQ ? 1024 : 256;
            const int col = (isQ ? 256 * (pn - 16) : 0) + 64 * wc + 8 * fq;
            float* o32p = out + (isK ? OUT_KP : OUT_VP); float* o32s = out + (isK ? OUT_KS : OUT_VS);
#pragma unroll
            for (int ai = 0; ai < 2; ++ai)
#pragma unroll
                for (int m = 0; m < 4; ++m) {
                    f32x4 v[2][2];
#pragma unroll
                    for (int bj = 0; bj < 2; ++bj)
#pragma unroll
                        for (int n = 0; n < 2; ++n) v[bj][n] = acc[ai][bj][m][n];
                    if (pn != 21) {
                        float ss = 0.f;
#pragma unroll
                        for (int bj = 0; bj < 2; ++bj)
#pragma unroll
                            for (int n = 0; n < 2; ++n) { const f32x4 x = v[bj][n]; ss += (x[0] * x[0] + x[1] * x[1]) + (x[2] * x[2] + x[3] * x[3]); }
                        ss += __shfl_xor(ss, 16); ss += __shfl_xor(ss, 32);
                        const float rs = __builtin_amdgcn_rsqf(ss * (1.0f / 64.0f) + RMS_EPS);
#pragma unroll
                        for (int bj = 0; bj < 2; ++bj)
#pragma unroll
                            for (int n = 0; n < 2; ++n) v[bj][n] = v[bj][n] * rs * w[bj][n];
                    }
                    const int lrow = lrow0 + ai * HALF + m * 16;
                    const size_t row = (size_t)pm * BM + lrow;
#pragma unroll
                    for (int bj = 0; bj < 2; ++bj) *(u32x4*)(O + row * ldo + col + 32 * bj) = pack8(v[bj][0], v[bj][1]);
                    if (!isQ) {
                        float* dst = nullptr;
                        if (pm == 128) dst = o32s + (size_t)lrow * 256 + col;
                        else if ((pm & 31) == 31 && ai == 1) dst = o32p + (size_t)((pm >> 5) * 128 + (lrow - 128)) * 256 + col;
                        if (dst) {
#pragma unroll
                            for (int bj = 0; bj < 2; ++bj) { *(f32x4*)(dst + 32 * bj) = v[bj][0]; *(f32x4*)(dst + 32 * bj + 4) = v[bj][1]; }
                        }
                    }
                }
        } else {
            const int col = 256 * (pn - 22) + 32 * wc + 8 * fq;
#pragma unroll
            for (int ai = 0; ai < 2; ++ai)
#pragma unroll
                for (int m = 0; m < 4; ++m) {
                    const size_t row = grow0 + ai * HALF + m * 16;
#pragma unroll
                    for (int bj = 0; bj < 2; ++bj) {
                        f32x4 r0, r1;
#pragma unroll
                        for (int j = 0; j < 1; ++j) { r0 = sigmoid255(acc[ai][bj][m][0]); r1 = sigmoid255(acc[ai][bj][m][1]); }
                        unsigned w0 = 0u, w1 = 0u;
                        w0 = __builtin_amdgcn_cvt_pk_u8_f32(r0[0], 0, w0); w0 = __builtin_amdgcn_cvt_pk_u8_f32(r0[1], 1, w0); w0 = __builtin_amdgcn_cvt_pk_u8_f32(r0[2], 2, w0); w0 = __builtin_amdgcn_cvt_pk_u8_f32(r0[3], 3, w0);
                        w1 = __builtin_amdgcn_cvt_pk_u8_f32(r1[0], 0, w1); w1 = __builtin_amdgcn_cvt_pk_u8_f32(r1[1], 1, w1); w1 = __builtin_amdgcn_cvt_pk_u8_f32(r1[2], 2, w1); w1 = __builtin_amdgcn_cvt_pk_u8_f32(r1[3], 3, w1);
                        typedef unsigned u32x2_t __attribute__((ext_vector_type(2)));
                        *(u32x2_t*)((unsigned char*)SG + row * 1024 + col + 128 * bj) = (u32x2_t){w0, w1};
                    }
                }
        }
    }
};

#ifndef NT_Y
#define NT_Y 0
#endif
#ifndef NT_XN
#define NT_XN 1
#endif
#ifndef NT_X1B
#define NT_X1B 1
#endif
#define NT_IFE(c, p) ((c) ? __builtin_nontemporal_load(p) : *(p))
#if NT_Y
#define NT_STORE(p, v) __builtin_nontemporal_store((v), (p))
#else
#define NT_STORE(p, v) (*(p) = (v))
#endif
struct EpiOut {
    static constexpr bool PERM = true, AFTER_DRAIN = false;
    const bf16_t* XN; const float* IR; const float* nw; bf16_t* X1B; float* SS; PG8_LAS float* ssbuf;
    struct Pre {}; __device__ __forceinline__ void prefetch(const Unit&, Pre&, int, int, int) const {}
    __device__ __forceinline__ void operator()(const f32x4 (&acc)[2][2][4][2], const Unit& u, int wr, int wc, int fr, int fq, const Pre&) const {
        asm volatile("" : "+v"(fr), "+v"(fq), "+s"(wr), "+s"(wc));
        const int pm = u.pm; const int col = 256 * u.pn + 32 * wc + 8 * fq;
        const int lrow0 = wr * 64 + fr;
        f32x4 iw[2][2];
#pragma unroll
        for (int bj = 0; bj < 2; ++bj)
#pragma unroll
            for (int n = 0; n < 2; ++n) { const f32x4 w4 = *(const __attribute__((address_space(1))) f32x4*)(nw + col + 128 * bj + 4 * n);
#pragma unroll
                for (int j = 0; j < 4; ++j) iw[bj][n][j] = __builtin_amdgcn_rcpf(w4[j]); }
#pragma unroll
        for (int ai = 0; ai < 2; ++ai) {
            u32x4 xw[4][2]; float ir[4];
#pragma unroll
            for (int m = 0; m < 4; ++m) { const size_t row = (size_t)pm * BM + lrow0 + ai * HALF + m * 16; ir[m] = IR[row];
#pragma unroll
                for (int bj = 0; bj < 2; ++bj) xw[m][bj] = NT_IFE(NT_XN, (const __attribute__((address_space(1))) u32x4*)(XN + row * 1024 + col + 128 * bj)); }
            asm volatile("" ::: "memory");
#pragma unroll
            for (int m = 0; m < 4; ++m) {
                const int lrow = lrow0 + ai * HALF + m * 16; const size_t row = (size_t)pm * BM + lrow;
                float ss = 0.f;
#pragma unroll
                for (int bj = 0; bj < 2; ++bj) {
                    const u32x4 w = xw[m][bj]; f32x4 x0, x1;
                    x0[0] = __uint_as_float(w.x << 16); x0[1] = __uint_as_float(w.x & 0xffff0000u); x0[2] = __uint_as_float(w.y << 16); x0[3] = __uint_as_float(w.y & 0xffff0000u);
                    x1[0] = __uint_as_float(w.z << 16); x1[1] = __uint_as_float(w.z & 0xffff0000u); x1[2] = __uint_as_float(w.w << 16); x1[3] = __uint_as_float(w.w & 0xffff0000u);
                    const f32x4 y0 = x0 * iw[bj][0] * ir[m] + acc[ai][bj][m][0], y1 = x1 * iw[bj][1] * ir[m] + acc[ai][bj][m][1];
                    ss += (y0[0] * y0[0] + y0[1] * y0[1]) + (y0[2] * y0[2] + y0[3] * y0[3]) + (y1[0] * y1[0] + y1[1] * y1[1]) + (y1[2] * y1[2] + y1[3] * y1[3]);
                    *(u32x4*)(X1B + row * 1024 + col + 128 * bj) = pack8(y0, y1);
                }
                ss += __shfl_xor(ss, 16); ss += __shfl_xor(ss, 32);
                if (fq == 0) ssbuf[lrow * 4 + wc] = ss;
            }
        }
        asm volatile("s_waitcnt lgkmcnt(0)" ::: "memory"); __builtin_amdgcn_s_barrier(); asm volatile("" ::: "memory");
        { const int t = threadIdx.x; if (t < 256) { const float a = ssbuf[t * 4 + 0], b = ssbuf[t * 4 + 1], c = ssbuf[t * 4 + 2], d = ssbuf[t * 4 + 3]; SS[(size_t)u.pn * MROWS + (size_t)pm * BM + t] = (a + b) + (c + d); } }
        asm volatile("s_waitcnt lgkmcnt(0)" ::: "memory"); __builtin_amdgcn_s_barrier(); asm volatile("" ::: "memory");
    }
};

struct EpiGU {
    static constexpr bool PERM = true, AFTER_DRAIN = false;
    const float* SS; bf16_t* H;
    struct Pre { float sv[2][4]; };
    __device__ __forceinline__ void prefetch(const Unit& u, Pre& p, int wr, int fr, int fq) const {
#pragma unroll
        for (int ai = 0; ai < 2; ++ai)
#pragma unroll
            for (int m = 0; m < 4; ++m) p.sv[ai][m] = SS[(size_t)fq * MROWS + (size_t)u.pm * BM + wr * 64 + fr + ai * HALF + m * 16];
    }
    __device__ __forceinline__ void operator()(const f32x4 (&acc)[2][2][4][2], const Unit& u, int wr, int wc, int fr, int fq, const Pre& pre) const {
        asm volatile("" : "+v"(fr), "+v"(fq), "+s"(wr), "+s"(wc));
        const int col = 128 * u.pn + 32 * wc + 8 * fq; const int lrow0 = wr * 64 + fr;
#pragma unroll
        for (int ai = 0; ai < 2; ++ai)
#pragma unroll
            for (int m = 0; m < 4; ++m) {
                const size_t row = (size_t)u.pm * BM + lrow0 + ai * HALF + m * 16;
                float ss = pre.sv[ai][m];
                ss += __shfl_xor(ss, 16); ss += __shfl_xor(ss, 32);
                const float ms = ss * (1.0f / 1024.0f) + RMS_EPS; const float rs = __builtin_amdgcn_rsqf(ms);
                const float c1 = -1.4426950408889634f * rs;
                const f32x4 msv = {ms, ms, ms, ms};
                const f32x4 t0 = acc[ai][0][m][0] * c1, t1 = acc[ai][0][m][1] * c1;
                f32x4 e0, e1;
#pragma unroll
                for (int j = 0; j < 4; ++j) { e0[j] = __builtin_amdgcn_exp2f(t0[j]); e1[j] = __builtin_amdgcn_exp2f(t1[j]); }
                e0 = e0 * ms + msv; e1 = e1 * ms + msv;
                f32x4 s0, s1;
#pragma unroll
                for (int j = 0; j < 4; ++j) { s0[j] = __builtin_amdgcn_rcpf(e0[j]); s1[j] = __builtin_amdgcn_rcpf(e1[j]); }
                const f32x4 r0 = (acc[ai][0][m][0] * acc[ai][1][m][0]) * s0, r1 = (acc[ai][0][m][1] * acc[ai][1][m][1]) * s1;
                *(u32x4*)(H + row * 2816 + col) = pack8(r0, r1);
            }
    }
};

struct EpiDown {
    static constexpr bool PERM = true, AFTER_DRAIN = false;
    float* Y; const bf16_t* X1B;
#ifdef EPI_TS
    unsigned long long* tsp;
#endif
    struct Pre {}; __device__ __forceinline__ void prefetch(const Unit&, Pre&, int, int, int) const {}
    __device__ __forceinline__ void operator()(const f32x4 (&acc)[2][2][4][2], const Unit& u, int wr, int wc, int fr, int fq, const Pre&) const {
        asm volatile("" : "+v"(fr), "+v"(fq), "+s"(wr), "+s"(wc));
        const int col = 256 * u.pn + 32 * wc + 8 * fq; const int lrow0 = wr * 64 + fr;
#ifdef EPI_TS
        const unsigned long long ts0 = __builtin_amdgcn_s_memrealtime();
#endif
        u32x4 xw[2][4][2];
#pragma unroll
        for (int ai = 0; ai < 2; ++ai)
#pragma unroll
            for (int m = 0; m < 4; ++m) { const size_t off = ((size_t)u.pm * BM + lrow0 + ai * HALF + m * 16) * 1024 + col;
#pragma unroll
                for (int bj = 0; bj < 2; ++bj) xw[ai][m][bj] = NT_IFE(NT_X1B, (const __attribute__((address_space(1))) u32x4*)(X1B + off + 128 * bj)); }
        asm volatile("" ::: "memory");
#ifdef EPI_TS
        asm volatile("s_waitcnt vmcnt(0)" ::: "memory"); const unsigned long long ts1 = __builtin_amdgcn_s_memrealtime();
#endif
#pragma unroll
        for (int ai = 0; ai < 2; ++ai)
#pragma unroll
            for (int m = 0; m < 4; ++m) {
                const size_t off = ((size_t)u.pm * BM + lrow0 + ai * HALF + m * 16) * 1024 + col;
#pragma unroll
                for (int bj = 0; bj < 2; ++bj) {
                    const u32x4 w = xw[ai][m][bj];
                    f32x4 x0, x1;
                    x0[0] = __uint_as_float(w.x << 16); x0[1] = __uint_as_float(w.x & 0xffff0000u); x0[2] = __uint_as_float(w.y << 16); x0[3] = __uint_as_float(w.y & 0xffff0000u);
                    x1[0] = __uint_as_float(w.z << 16); x1[1] = __uint_as_float(w.z & 0xffff0000u); x1[2] = __uint_as_float(w.w << 16); x1[3] = __uint_as_float(w.w & 0xffff0000u);
                    NT_STORE((f32x4*)(Y + off + 128 * bj), x0 + acc[ai][bj][m][0]); NT_STORE((f32x4*)(Y + off + 128 * bj + 4), x1 + acc[ai][bj][m][1]);
                }
            }
#ifdef EPI_TS
        asm volatile("s_waitcnt vmcnt(0)" ::: "memory"); const unsigned long long ts2 = __builtin_amdgcn_s_memrealtime();
        if (threadIdx.x == 0 && u.pm < 128) { unsigned long long* tp = tsp + 2048; tp[blockIdx.x] += ts1 - ts0; tp[256 + blockIdx.x] += ts2 - ts1; const unsigned long long n = tp[512 + blockIdx.x]; tp[512 + blockIdx.x] = n + 1; if (n < 2) { tp[1024 + blockIdx.x * 4 + n * 2] = ts0; tp[1024 + blockIdx.x * 4 + n * 2 + 1] = ts2; } }
#endif
    }
};
template <class Epi, class Sched, bool ALIGN_EPI = false, bool SP2 = false, int AUXA = 0  >
__device__ __forceinline__ void gemm_phase(PG8_LAS unsigned char* lds, const Gemm g, const Sched& S, const Epi& E) {
    int tid_ = threadIdx.x; asm volatile("" : "+v"(tid_));
    const int tid = tid_, wid = __builtin_amdgcn_readfirstlane(tid >> 6), lane = tid & 63, wr = wid >> 2, wc = wid & 3, fr = lane & 15, fq = lane >> 4;
    const int K = g.K, nt = K / BK;
    unsigned voffA[2], voffB[2];
#pragma unroll
    for (int i = 0; i < 2; ++i) { int R, C; stage_rc(tid * 16 + i * 8192, R, C); const int Rb = Epi::PERM ? ((R & ~31) + perm32(R & 31)) : R;
        voffA[i] = (unsigned)(R * K + C) * 2u; voffB[i] = (unsigned)(Rb * K + C) * 2u; }
    const size_t kstep = (size_t)(BK * 2);
    const size_t hstep = (size_t)HALF * K * 2;
    const size_t tstep = 2 * hstep;
    const unsigned ldsw = (unsigned)wid * 1024u;
    const int aoff = lds_byte(wr * 64 + fr, fq * 8), boff = lds_byte(wc * 32 + fr, fq * 8);
#define PG8_SA(b, h) (((b) * 2 + (h)) * HTB)
#define PG8_SB(b, h) ((4 + (b) * 2 + (h)) * HTB)
#define PG8_STAGE_X(bufoff, gbase, voff, AUX_) do { _Pragma("unroll") for (int _i = 0; _i < 2; ++_i) \
        __builtin_amdgcn_global_load_lds((const unsigned*)((const char*)(gbase) + (voff)[_i]), (PG8_LAS unsigned*)(lds + (bufoff) + ldsw + _i * 8192), 16, 0, AUX_); } while (0)
#define PG8_STAGE(bufoff, gbase, voff) do { if constexpr (AUXA == 2) { if (&(voff) == &voffA) PG8_STAGE_X(bufoff, gbase, voff, 2); else PG8_STAGE_X(bufoff, gbase, voff, 0); } else PG8_STAGE_X(bufoff, gbase, voff, 0); } while (0)
#define PG8_LDA(dst, b, h) do { _Pragma("unroll") for (int m = 0; m < 4; ++m) _Pragma("unroll") for (int k = 0; k < 2; ++k) dst[m][k] = *(const PG8_LAS bf16x8*)(lds + PG8_SA(b, h) + aoff + m * 2048 + k * 1024); } while (0)
#define PG8_LDB(dst, b, h) do { _Pragma("unroll") for (int n = 0; n < 2; ++n) _Pragma("unroll") for (int k = 0; k < 2; ++k) dst[n][k] = *(const PG8_LAS bf16x8*)(lds + PG8_SB(b, h) + boff + n * 2048 + k * 1024); } while (0)
#define PG8_MMA(ai, bj, At, Bt) do { __builtin_amdgcn_s_setprio(1); _Pragma("unroll") for (int m = 0; m < 4; ++m) _Pragma("unroll") for (int n = 0; n < 2; ++n) _Pragma("unroll") for (int k = 0; k < 2; ++k) \
        acc[ai][bj][m][n] = __builtin_amdgcn_mfma_f32_16x16x32_bf16(Bt[n][k], At[m][k], acc[ai][bj][m][n], 0, 0, 0); __builtin_amdgcn_s_setprio(0); } while (0)
#define PG8_WAIT_V(n) asm volatile("s_waitcnt vmcnt(" #n ")" ::: "memory")
#define PG8_WAIT_L(n) asm volatile("s_waitcnt lgkmcnt(" #n ")" ::: "memory")
#define PG8_BAR __builtin_amdgcn_s_barrier()
#define PG8_SCHED __builtin_amdgcn_sched_barrier(0)
    Unit cur, nxt; int ui = 0;
    if (!S.next(0, cur)) return;
    typename Epi::Pre pre;
    f32x4 acc[2][2][4][2];
#pragma unroll
    for (int a = 0; a < 2; ++a)
#pragma unroll
        for (int b = 0; b < 2; ++b)
#pragma unroll
            for (int m = 0; m < 4; ++m)
#pragma unroll
                for (int n = 0; n < 2; ++n) acc[a][b][m][n] = (f32x4){0.f, 0.f, 0.f, 0.f};
    bf16x8 At[4][2], B0[2][2], B1[2][2];
    const char* cA = (const char*)g.A + (size_t)(cur.pm & g.amask) * tstep; const char* cB = (const char*)g.Bt + (size_t)(cur.pn & g.bmask) * tstep;
    S.a_ready(cur);
    if constexpr (SP2) {
        PG8_STAGE(PG8_SB(0, 0), cB, voffB); PG8_STAGE(PG8_SB(0, 1), cB + hstep, voffB); PG8_STAGE(PG8_SA(0, 0), cA, voffA); PG8_STAGE(PG8_SA(0, 1), cA + hstep, voffA);
        if (wr == 1) PG8_BAR;
        PG8_WAIT_V(2); PG8_BAR;
        PG8_STAGE(PG8_SB(1, 0), cB + kstep, voffB); PG8_STAGE(PG8_SA(1, 0), cA + kstep, voffA); PG8_STAGE(PG8_SB(1, 1), cB + hstep + kstep, voffB);
        PG8_WAIT_V(6); PG8_BAR;
    } else {
        PG8_STAGE(PG8_SB(0, 0), cB, voffB); PG8_STAGE(PG8_SA(0, 0), cA, voffA); PG8_STAGE(PG8_SB(0, 1), cB + hstep, voffB); PG8_STAGE(PG8_SA(0, 1), cA + hstep, voffA);
        if (wr == 1) PG8_BAR;
        PG8_WAIT_V(4); PG8_BAR;
        PG8_STAGE(PG8_SB(1, 0), cB + kstep, voffB); PG8_STAGE(PG8_SA(1, 0), cA + kstep, voffA); PG8_STAGE(PG8_SB(1, 1), cB + hstep + kstep, voffB);
        PG8_WAIT_V(6); PG8_BAR;
    }
    for (;;) {
        const bool has_next = S.next(ui + 1, nxt);
        const char* nA = has_next ? (const char*)g.A + (size_t)(nxt.pm & g.amask) * tstep : cA; const char* nB = has_next ? (const char*)g.Bt + (size_t)(nxt.pn & g.bmask) * tstep : cB;
        for (int t = 0; t < nt; t += 2) {
            const bool last = (t == nt - 2);
            const char* a1 = cA + (size_t)(t + 1) * kstep;
            const char* a2 = last ? nA : cA + (size_t)(t + 2) * kstep; const char* b2 = last ? nB : cB + (size_t)(t + 2) * kstep;
            const char* a3 = a2 + kstep; const char* b3 = b2 + kstep;
            if (last && has_next) S.a_ready(nxt);
            if (last) E.prefetch(cur, pre, wr, fr, fq);
            if constexpr (SP2) {
            PG8_LDB(B0, 0, 0); PG8_LDB(B1, 0, 1); PG8_SCHED; PG8_LDA(At, 0, 0); PG8_STAGE(PG8_SA(1, 1), a1 + hstep, voffA);
            PG8_WAIT_V(8); PG8_WAIT_L(0); PG8_BAR; PG8_MMA(0, 0, At, B0); PG8_MMA(0, 1, At, B1); PG8_BAR; PG8_SCHED;
            PG8_LDA(At, 0, 1); PG8_STAGE(PG8_SB(0, 0), b2, voffB); PG8_STAGE(PG8_SB(0, 1), b2 + hstep, voffB); PG8_STAGE(PG8_SA(0, 0), a2, voffA);
            PG8_WAIT_V(8); PG8_WAIT_L(0); PG8_BAR; PG8_MMA(1, 0, At, B0); PG8_MMA(1, 1, At, B1); PG8_BAR; PG8_SCHED;
            PG8_LDB(B0, 1, 0); PG8_LDB(B1, 1, 1); PG8_SCHED; PG8_LDA(At, 1, 0); PG8_STAGE(PG8_SA(0, 1), a2 + hstep, voffA);
            PG8_WAIT_V(8); PG8_WAIT_L(0); PG8_BAR; PG8_MMA(0, 0, At, B0); PG8_MMA(0, 1, At, B1); PG8_BAR; PG8_SCHED;
            PG8_LDA(At, 1, 1); PG8_STAGE(PG8_SB(1, 0), b3, voffB); PG8_STAGE(PG8_SB(1, 1), b3 + hstep, voffB); PG8_STAGE(PG8_SA(1, 0), a3, voffA);
            PG8_WAIT_V(8); PG8_WAIT_L(0); PG8_BAR; PG8_MMA(1, 0, At, B0); PG8_MMA(1, 1, At, B1); PG8_BAR; PG8_SCHED;
            } else {
            PG8_LDB(B0, 0, 0); PG8_SCHED; PG8_LDA(At, 0, 0); PG8_STAGE(PG8_SA(1, 1), a1 + hstep, voffA);
            PG8_WAIT_L(8); PG8_BAR; PG8_WAIT_L(0); PG8_MMA(0, 0, At, B0); PG8_BAR; PG8_SCHED;
            PG8_LDB(B1, 0, 1); PG8_STAGE(PG8_SB(0, 0), b2, voffB);
            PG8_BAR; PG8_WAIT_L(0); PG8_MMA(0, 1, At, B1); PG8_BAR;
            PG8_LDA(At, 0, 1); PG8_STAGE(PG8_SA(0, 0), a2, voffA);
            PG8_BAR; PG8_WAIT_L(0); PG8_MMA(1, 0, At, B0); PG8_BAR; PG8_SCHED;
            PG8_STAGE(PG8_SB(0, 1), b2 + hstep, voffB);
            PG8_WAIT_V(6); PG8_BAR; PG8_MMA(1, 1, At, B1); PG8_BAR;
            PG8_LDB(B0, 1, 0); PG8_SCHED; PG8_LDA(At, 1, 0); PG8_STAGE(PG8_SA(0, 1), a2 + hstep, voffA);
            PG8_WAIT_L(8); PG8_BAR; PG8_WAIT_L(0); PG8_MMA(0, 0, At, B0); PG8_BAR; PG8_SCHED;
            PG8_LDB(B1, 1, 1); PG8_STAGE(PG8_SB(1, 0), b3, voffB);
            PG8_BAR; PG8_WAIT_L(0); PG8_MMA(0, 1, At, B1); PG8_BAR;
            PG8_LDA(At, 1, 1); PG8_STAGE(PG8_SA(1, 0), a3, voffA);
            PG8_BAR; PG8_WAIT_L(0); PG8_MMA(1, 0, At, B0); PG8_BAR; PG8_SCHED;
            PG8_STAGE(PG8_SB(1, 1), b3 + hstep, voffB);
            PG8_WAIT_V(6); PG8_BAR; PG8_MMA(1, 1, At, B1); PG8_BAR;
            }
        }
        if constexpr (ALIGN_EPI) { if (wr == 0) PG8_BAR; }
        if constexpr (!Epi::AFTER_DRAIN) { E(acc, cur, wr, wc, fr, fq, pre); S.done(cur); }
        if (!has_next) break;
#pragma unroll
        for (int a = 0; a < 2; ++a)
#pragma unroll
            for (int b = 0; b < 2; ++b)
#pragma unroll
                for (int m = 0; m < 4; ++m)
#pragma unroll
                    for (int n = 0; n < 2; ++n) acc[a][b][m][n] = (f32x4){0.f, 0.f, 0.f, 0.f};
        cur = nxt; cA = nA; cB = nB; ++ui;
        if constexpr (ALIGN_EPI) { if (wr == 1) PG8_BAR; }
    }
    PG8_WAIT_V(0);
    if constexpr (!ALIGN_EPI) { if (wr == 0) PG8_BAR; }
    PG8_BAR;
    if constexpr (Epi::AFTER_DRAIN) { E.fused(acc, cur, wr, wc, fr, fq, lds, wid, lane); S.done(cur); }
#undef PG8_SA
#undef PG8_SB
#undef PG8_STAGE
#undef PG8_STAGE_X
#undef PG8_LDA
#undef PG8_LDB
#undef PG8_MMA
#undef PG8_WAIT_V
#undef PG8_WAIT_L
#undef PG8_BAR
#undef PG8_SCHED
}
}
#define GAS __attribute__((address_space(1)))
#define LAS __attribute__((address_space(3)))
typedef unsigned short bf16;
typedef unsigned v4u __attribute__((ext_vector_type(4)));
typedef float f32x4 __attribute__((ext_vector_type(4)));
typedef short bf16x8 __attribute__((ext_vector_type(8)));
typedef GAS unsigned gu32;
typedef GAS unsigned long long gu64;
#define RLX_AGENT __ATOMIC_RELAXED, __HIP_MEMORY_SCOPE_AGENT
#define LDS_WAIT() asm volatile("s_waitcnt lgkmcnt(0)" ::: "memory")
#define VM_WAIT() asm volatile("s_waitcnt vmcnt(0)" ::: "memory")
__device__ __forceinline__ unsigned long long rt() { return __builtin_amdgcn_s_memrealtime(); }
__device__ __forceinline__ unsigned f2bf(float f) { unsigned u = __builtin_bit_cast(unsigned, f); return (u + 0x7fffu + ((u >> 16) & 1u)) >> 16; }
__device__ __forceinline__ unsigned pk2(float lo, float hi) { return f2bf(lo) | (f2bf(hi) << 16); }

#define XB_TMO      128
#define XB_XCNT(j)  (256  + 64 * (j))
#define XB_XSUB(j)  (1280 + 64 * (j))
#define XB_XGEN(j)  (2304 + 64 * (j))
#define XB_TOP      3328
#define XB_TOPGEN   3392
#define XCD_BAR_WORDS 3456
#define XB_SPIN_CAP (1u << 18)

__device__ __forceinline__ unsigned xb_ld(unsigned* p)              { return __hip_atomic_load(p, __ATOMIC_RELAXED, __HIP_MEMORY_SCOPE_AGENT); }
__device__ __forceinline__ unsigned xb_add(unsigned* p, unsigned v) { return __hip_atomic_fetch_add(p, v, __ATOMIC_RELAXED, __HIP_MEMORY_SCOPE_AGENT); }
__device__ __forceinline__ unsigned xb_xcc_id() { return (unsigned)__builtin_amdgcn_s_getreg((3 << 11) | 20) & 0xFu; }
#define XB_SPIN(cond, bar) do { unsigned _sp = 0; while (cond) { __builtin_amdgcn_s_sleep(1); \
    if ((++_sp & 255u) == 0u) { if (xb_ld(&(bar)[XB_TMO])) break; if (_sp > XB_SPIN_CAP) { atomicAdd(&(bar)[XB_TMO], 1u); break; } } } } while (0)

struct XcdBarrier {
    unsigned* bar; unsigned x;
    volatile LAS unsigned* st;
};

__device__ __forceinline__ XcdBarrier xcd_barrier_post(unsigned* bar, volatile LAS unsigned* st) {
    XcdBarrier b; b.bar = bar; b.x = xb_xcc_id(); b.st = st;
    if (threadIdx.x == 0) (void)xb_add(&bar[XB_XCNT(b.x)], 1u);
    return b;
}
__device__ __forceinline__ void xcd_barrier_complete(unsigned* bar, unsigned x, unsigned& nloc, unsigned& nx) {
    const unsigned G = gridDim.x * gridDim.y * gridDim.z;
    unsigned sum, cnt, mine, sp = 0u;
    for (;;) {
        sum = 0u; cnt = 0u; mine = 0u;
#pragma unroll
        for (unsigned j = 0; j < 16; ++j) { const unsigned c = xb_ld(&bar[XB_XCNT(j)]); sum += c; cnt += (c > 0u) ? 1u : 0u; mine = (j == x) ? c : mine; }
        if (sum == G) break;
        __builtin_amdgcn_s_sleep(1);
        if ((++sp & 255u) == 0u) { if (xb_ld(&bar[XB_TMO])) break; if (sp > XB_SPIN_CAP) { atomicAdd(&bar[XB_TMO], 1u); break; } }
    }
    nloc = mine > 0u ? mine : 1u; nx = cnt > 0u ? cnt : 1u;
}

__device__ __forceinline__ void xcd_barrier(const XcdBarrier& b) {
    asm volatile("s_waitcnt vmcnt(0)" ::: "memory");
    __syncthreads();
    if (threadIdx.x == 0) {
        unsigned* bar = b.bar;
        __builtin_amdgcn_s_waitcnt(0);
        unsigned nloc = b.st[0], nx = b.st[1];
        if (nloc == 0u) { xcd_barrier_complete(bar, b.x, nloc, nx); b.st[0] = nloc; b.st[1] = nx; }
        const unsigned old = xb_add(&bar[XB_XSUB(b.x)], 1u);
        const unsigned gen = old / nloc;
        if (old + 1u == (gen + 1u) * nloc) {
            __builtin_amdgcn_fence(__ATOMIC_RELEASE, "agent");
            asm volatile("s_waitcnt vmcnt(0)" ::: "memory");
            const unsigned og = xb_add(&bar[XB_TOP], 1u);
            const unsigned tg = og / nx;
            if (og + 1u == (tg + 1u) * nx) xb_add(&bar[XB_TOPGEN], 1u);
            else XB_SPIN(xb_ld(&bar[XB_TOPGEN]) == tg, bar);
            __builtin_amdgcn_fence(__ATOMIC_ACQUIRE, "agent");
            xb_add(&bar[XB_XGEN(b.x)], 1u);
            asm volatile("s_waitcnt vmcnt(0)" ::: "memory");
        } else {
            XB_SPIN(xb_ld(&bar[XB_XGEN(b.x)]) == gen, bar);
            __builtin_amdgcn_fence(__ATOMIC_ACQUIRE, "agent");
            asm volatile("s_waitcnt vmcnt(0)" ::: "memory");
        }
    }
    __syncthreads();
}
constexpr int NWAVES = 8;
constexpr int D = 1024, MROWS = pg8::MROWS, MP = pg8::MP, SEQ_T = 8192, NB = 4, NCH = 128, DFF = 2816, NIN = 6656, NGU = 5632;
constexpr int DEC_B = 16, DEC_T = 16, CACHE_L = 128;
constexpr size_t MiB = 1u << 20;
constexpr size_t WS_CTL = 0, CTL_ZERO_BYTES = 64 * 1024;
constexpr size_t WS_SS = 2 * MiB, WS_CK = 5 * MiB, WS_CV = 6 * MiB;
constexpr size_t WS_WIN = 8 * MiB, WS_WOUT = 21 * MiB, WS_WGU = 23 * MiB, WS_WD = 34 * MiB;
constexpr size_t WS_XN = 40 * MiB;
constexpr size_t WS_Q = 105 * MiB;
constexpr size_t WS_K = 170 * MiB, WS_V = 187 * MiB;
constexpr size_t WS_U = 204 * MiB, WS_BG = 269 * MiB, WS_SG = 334 * MiB;
constexpr size_t WS_H = 204 * MiB;
constexpr size_t WS_HS = 399 * MiB;
constexpr size_t WS_MGS = 401 * MiB;
constexpr size_t WS_MG = 402 * MiB;
constexpr size_t WS_IR = 467 * MiB;
constexpr size_t WS_END = 468 * MiB;
static_assert(WS_SS + (size_t)MROWS * 16 * 4 <= WS_CK && WS_WIN + (size_t)NIN * D * 2 <= WS_WOUT && WS_WGU + (size_t)NGU * D * 2 <= WS_WD && WS_WD + (size_t)D * DFF * 2 <= WS_XN, "ws map 1");
static_assert(WS_XN + (size_t)MROWS * D * 2 <= WS_Q && WS_Q + (size_t)MROWS * D * 2 <= WS_K && WS_K + (size_t)(MROWS + 64) * 256 * 2 <= WS_V && WS_V + (size_t)(MROWS + 64) * 256 * 2 <= WS_U, "ws map 2");
static_assert(WS_U + (size_t)MROWS * D * 2 <= WS_BG && WS_BG + (size_t)MROWS * D * 2 <= WS_SG && WS_SG + (size_t)MROWS * D * 2 <= WS_HS && WS_H + (size_t)MROWS * DFF * 2 <= WS_HS && WS_HS + (size_t)256 * DFF * 2 <= WS_MGS && WS_MGS + (size_t)256 * D * 2 <= WS_MG && WS_MG + (size_t)MROWS * D * 2 <= WS_IR && WS_IR + (size_t)MROWS * 4 <= WS_END, "ws map 3");
static_assert(WS_Q == pg8::EO_Q && WS_K == pg8::EO_K && WS_V == pg8::EO_V && WS_U == pg8::EO_U && WS_BG == pg8::EO_BG && WS_SG == pg8::EO_SG, "epilogue offsets");
constexpr int CW_TMO = 0, CW_CODE = 1, CW_BAR = 4096;
static_assert((CW_BAR + 3456) * 4 <= (int)CTL_ZERO_BYTES, "control words inside the per-call memset");

constexpr int RING_OFF = 0, RING_BYTES = 131072;
constexpr int LDSCTL_OFF = 139264, MISC_OFF = LDSCTL_OFF + 320;
constexpr int LDS_BYTES = 147456;

struct Frame {
    LAS unsigned char* lds;
    volatile LAS unsigned* MISC;
    gu32* ctl;
    int tid, lane, wave;
    int vcu, G;
    const float *xp, *xs, *state_conv, *cache_k, *cache_v, *norm_mix_w, *w_in, *conv_w, *q_norm_w, *k_norm_w, *sinks, *w_out, *norm_ffn_w, *w_gate, *w_up, *w_down;
    float* out;
    bf16 *Win_t, *Wout_t, *Wgu_t, *Wd_t;
    bf16 *XN, *MG, *Q, *X1B, *KB, *VB, *U, *BG, *SG, *H, *CK, *CV;
    float* SS; float* IR;
};

#ifndef NT_P0
#define NT_P0 1
#endif
#ifndef NT_MRG
#define NT_MRG 1
#endif
#ifndef NT_Q
#define NT_Q 0
#endif
#define NT_IF(c, p) ((c) ? __builtin_nontemporal_load(p) : *(p))
#if NT_P0
#define NT_LOAD(p) __builtin_nontemporal_load(p)
#else
#define NT_LOAD(p) (*(p))
#endif
__device__ __forceinline__ float wave_sum(float v) {
#pragma unroll
    for (int o = 1; o < 64; o <<= 1) v += __shfl_xor(v, o);
    return v;
}
struct WItem { const float* W; bf16* WT; const float* sc; int K, N, k0, n0, drow0; };
__device__ __forceinline__ void p0_item_load(const WItem& w, f32x4 (&t)[8], int lane) {
#pragma unroll
    for (int i = 0; i < 8; ++i) t[i] = NT_LOAD((const GAS f32x4*)(w.W + (size_t)(w.k0 + 8 * i + (lane >> 3)) * w.N + w.n0 + 4 * (lane & 7)));
}
__device__ __forceinline__ void p0_item_finish(const WItem& w, const f32x4 (&t)[8], LAS float* scr, int lane) {
#pragma unroll
    for (int i = 0; i < 8; ++i) { const int kk = 8 * i + (lane >> 3); f32x4 v = t[i]; if (w.sc) v = v * w.sc[w.k0 + kk]; LAS float* d = scr + kk * 33 + 4 * (lane & 7); d[0] = v.x; d[1] = v.y; d[2] = v.z; d[3] = v.w; }
    LDS_WAIT(); asm volatile("" ::: "memory");
    const int c = lane & 7;
#pragma unroll
    for (int j = 0; j < 4; ++j) { const int n = (lane >> 3) + 8 * j; const LAS float* s = scr + (8 * c) * 33 + n;
        v4u o; o.x = pk2(s[0 * 33], s[1 * 33]); o.y = pk2(s[2 * 33], s[3 * 33]); o.z = pk2(s[4 * 33], s[5 * 33]); o.w = pk2(s[6 * 33], s[7 * 33]);
        *(GAS v4u*)(w.WT + (size_t)(w.drow0 + n) * w.K + w.k0 + 8 * c) = o; }
    LDS_WAIT(); asm volatile("" ::: "memory");
}
__device__ __forceinline__ int win_dest_row(int n) {
    if (n < 1024) return 256 * (n >> 7) + (n & 127);
    if (n < 2048) { const int q = n - 1024; return 256 * (8 + (q >> 7)) + (q & 127); }
    if (n < 3072) { const int q = n - 2048; return 256 * (q >> 7) + 128 + (q & 127); }
    if (n < 4608) { const int q = n - 3072; const int t = q >> 8, r = q & 255;
                    return 256 * (16 + t) + 128 * ((r >> 5) & 1) + 32 * (r >> 6) + (r & 31); }
    if (n < 5632) { const int q = n - 4608; return 256 * (8 + (q >> 7)) + 128 + (q & 127); }
    return 256 * 22 + (n - 5632);
}
__device__ __forceinline__ void rms_row_to_bf16(Frame& F, const float* xrow, const float* w, bf16* orow) {
    const GAS f32x4* xr = (const GAS f32x4*)xrow + F.lane; const GAS f32x4* wr = (const GAS f32x4*)w + F.lane;
    f32x4 v[4]; float s2 = 0.f;
#pragma unroll
    for (int j = 0; j < 4; ++j) { v[j] = xr[64 * j]; s2 += (v[j].x * v[j].x + v[j].y * v[j].y) + (v[j].z * v[j].z + v[j].w * v[j].w); }
    const float rstd = __builtin_amdgcn_rsqf(wave_sum(s2) * (1.f / D) + pg8::RMS_EPS);
    GAS unsigned long long* o8 = (GAS unsigned long long*)orow + F.lane;
#pragma unroll
    for (int j = 0; j < 4; ++j) { const f32x4 ww = wr[64 * j]; o8[64 * j] = (unsigned long long)pk2(v[j].x * rstd * ww.x, v[j].y * rstd * ww.y) | ((unsigned long long)pk2(v[j].z * rstd * ww.z, v[j].w * rstd * ww.w) << 32); }
}
constexpr int I_IN = (D / 64) * (NIN / 32), I_O = (D / 64) * (D / 32), I_G = (D / 64) * (DFF / 32), I_D = (DFF / 64) * (D / 32);
__device__ __forceinline__ void p0_item_decode(Frame& F, int it, WItem& w) {
    int r = it; w.sc = nullptr;
    if (r < I_IN) { const int nblk = NIN / 32, kb = r / nblk, nb = r % nblk; w.W = F.w_in; w.K = D; w.N = NIN; w.WT = F.Win_t; w.k0 = 64 * kb; w.n0 = 32 * nb; w.drow0 = win_dest_row(32 * nb); return; } r -= I_IN;
    if (r < I_O) { const int nblk = D / 32, kb = r / nblk, nb = r % nblk; w.W = F.w_out; w.K = D; w.N = D; w.WT = F.Wout_t; w.k0 = 64 * kb; w.n0 = 32 * nb; w.drow0 = 32 * nb; return; } r -= I_O;
    if (r < 2 * I_G) { const int up = r >= I_G; if (up) r -= I_G; const int nblk = DFF / 32, kb = r / nblk, nb = r % nblk, n0 = 32 * nb;
        w.W = up ? F.w_up : F.w_gate; w.K = D; w.N = DFF; w.WT = F.Wgu_t; w.k0 = 64 * kb; w.n0 = n0; w.drow0 = 256 * (n0 >> 7) + 128 * up + (n0 & 127); w.sc = F.norm_ffn_w; return; } r -= 2 * I_G;
    { const int nblk = D / 32, kb = r / nblk, nb = r % nblk; w.W = F.w_down; w.K = DFF; w.N = D; w.WT = F.Wd_t; w.k0 = 64 * kb; w.n0 = 32 * nb; w.drow0 = 32 * nb; }
}
__device__ __forceinline__ void p0_weight_range(Frame& F, int first, int count, int start, int step) {
    LAS float* scr = (LAS float*)(F.lds + RING_OFF + F.wave * 16384);
    int it = start; if (it >= count) return;
    WItem A, B; f32x4 ta[8], tb[8];
    p0_item_decode(F, first + it, A); p0_item_load(A, ta, F.lane);
    for (;;) {
        const int itn = it + step; const bool hn = itn < count;
        if (hn) { p0_item_decode(F, first + itn, B); p0_item_load(B, tb, F.lane); }
        p0_item_finish(A, ta, scr, F.lane);
        if (!hn) break;
        it = itn + step; const bool hn2 = it < count;
        if (hn2) { p0_item_decode(F, first + it, A); p0_item_load(A, ta, F.lane); }
        p0_item_finish(B, tb, scr, F.lane);
        if (!hn2) break;
    }
}
__device__ __forceinline__ void p0_weight_items(Frame& F, int first, int count, int w, int nw) { p0_weight_range(F, first, count, w * NWAVES + F.wave, nw * NWAVES); }
__device__ __forceinline__ void p0_prologue(Frame& F, bool defer_w) {
    LAS float* scr = (LAS float*)(F.lds + RING_OFF + F.wave * 16384);
    const int gw = F.vcu * NWAVES + F.wave, NGW = F.G * NWAVES;
    const int NITEMS = defer_w ? I_IN : I_IN + I_O + 2 * I_G + I_D;
    f32x4 nw[4];
#pragma unroll
    for (int j = 0; j < 4; ++j) nw[j] = ((const GAS f32x4*)F.norm_mix_w)[F.lane + 64 * j];
#define P0_LOADG(V, M0) do { _Pragma("unroll") for (int r = 0; r < 4; ++r) { const int m = (M0) + r * NGW; if (m < MROWS) { \
        const GAS f32x4* xr = (const GAS f32x4*)(m < MP ? F.xp + (size_t)m * D : F.xs + (size_t)(m - MP) * D) + F.lane; \
        _Pragma("unroll") for (int j = 0; j < 4; ++j) V[r][j] = NT_LOAD(xr + 64 * j); } } } while (0)
#define P0_DOG(V, M0) do { _Pragma("unroll") for (int r = 0; r < 4; ++r) { const int m = (M0) + r * NGW; if (m < MROWS) { \
        float s2 = 0.f; \
        _Pragma("unroll") for (int j = 0; j < 4; ++j) s2 += (V[r][j].x * V[r][j].x + V[r][j].y * V[r][j].y) + (V[r][j].z * V[r][j].z + V[r][j].w * V[r][j].w); \
        const float ms = wave_sum(s2) * (1.f / D) + pg8::RMS_EPS; const float rstd = __builtin_amdgcn_rsqf(ms); \
        if (F.lane == 0) F.IR[m] = __builtin_sqrtf(ms); \
        GAS unsigned long long* o8 = (GAS unsigned long long*)(F.XN + (size_t)m * D) + F.lane; \
        _Pragma("unroll") for (int j = 0; j < 4; ++j) o8[64 * j] = (unsigned long long)pk2(V[r][j].x * rstd * nw[j].x, V[r][j].y * rstd * nw[j].y) | ((unsigned long long)pk2(V[r][j].z * rstd * nw[j].z, V[r][j].w * rstd * nw[j].w) << 32); } } } while (0)
    f32x4 va[4][4], vb[4][4];
    P0_LOADG(va, gw);
    p0_weight_range(F, 0, NITEMS, gw, NGW);
    for (int m0 = gw; m0 < MROWS; m0 += 8 * NGW) {
        P0_LOADG(vb, m0 + 4 * NGW); P0_DOG(va, m0);
        P0_LOADG(va, m0 + 8 * NGW); P0_DOG(vb, m0 + 4 * NGW);
    }
#undef P0_LOADG
#undef P0_DOG
    { const int gt = gw * 64 + F.lane, NT = NGW * 64;
      for (int i = gt; i < DEC_B * CACHE_L * 256 / 4; i += NT) {
          const f32x4 a = ((const GAS f32x4*)F.cache_k)[i], b = ((const GAS f32x4*)F.cache_v)[i];
          ((GAS unsigned long long*)F.CK)[i] = (unsigned long long)pk2(a.x, a.y) | ((unsigned long long)pk2(a.z, a.w) << 32);
          ((GAS unsigned long long*)F.CV)[i] = (unsigned long long)pk2(b.x, b.y) | ((unsigned long long)pk2(b.z, b.w) << 32); }
      for (int i = gt; i < 64 * 256 / 4; i += NT) { ((GAS unsigned long long*)(F.KB + (size_t)MROWS * 256))[i] = 0ull; ((GAS unsigned long long*)(F.VB + (size_t)MROWS * 256))[i] = 0ull; } }
}

namespace p2 {
using bf16x8 = __attribute__((ext_vector_type(8))) short;
using s16x4 = __attribute__((ext_vector_type(4))) short;
using f32x16 = __attribute__((ext_vector_type(16))) float;
typedef short v4i16_t __attribute__((ext_vector_type(4)));
typedef LAS const char* lds_cptr;
constexpr int LDS_K = 0, LDS_V = 3 * 8192, LDS_WS = 6 * 8192, LDS_OST = LDS_WS + 8 * 256, LDS_TOTAL = LDS_OST + 8 * 4096;
__device__ __forceinline__ int crow(int r, int hi) { return (r & 3) + 8 * (r >> 2) + 4 * hi; }
__device__ __forceinline__ s16x4 vtr(lds_cptr p) { return __builtin_bit_cast(s16x4, __builtin_amdgcn_ds_read_tr16_b64_v4i16((LAS v4i16_t*)p)); }
__device__ __forceinline__ unsigned cvtpk(float lo, float hi) { return pg8::cvt_pk_bf16(lo, hi); }
__device__ __forceinline__ float bf_lo(unsigned w) { return __uint_as_float(w << 16); }
__device__ __forceinline__ float bf_hi(unsigned w) { return __uint_as_float(w & 0xffff0000u); }

#ifdef P2_TS
#define P2TS_PARAM , unsigned long long p2ts_c
#define P2TS_ARG , p2ts_c
#else
#define P2TS_PARAM
#define P2TS_ARG
#endif
struct UnitDesc { const bf16* kt[3]; const bf16* vt[3]; int nv[3]; int row0; int g; int sample; int t0; };
constexpr int SET_BYTES = 6 * 8192;
constexpr int LDS_WS2 = 2 * SET_BYTES, LDS_OST2 = LDS_WS2 + 8 * 256, LDS_TOTAL2 = LDS_OST2 + 8 * 4096;

__device__ __forceinline__ void make_prompt_unit(Frame& F, int id, UnitDesc& ud) {
    const int bg = id >> 7, c = id & 127, b = bg >> 2, g = bg & 3;
    ud.g = g; ud.sample = 0; ud.row0 = b * SEQ_T + 64 * c; ud.t0 = 64 * c;
#pragma unroll
    for (int j = 0; j < 3; ++j) { const int cc = c - 2 + j; const int cl = cc < 0 ? 0 : cc; ud.nv[j] = cc < 0 ? 0 : 64;
        const size_t off = (size_t)(b * SEQ_T + 64 * cl) * 256 + 64 * g; ud.kt[j] = F.KB + off; ud.vt[j] = F.VB + off; }
}
__device__ __forceinline__ void make_sample_unit(Frame& F, int id, UnitDesc& ud) {
    const int bs = id >> 2, g = id & 3;
    ud.g = g; ud.sample = 1; ud.row0 = MP + DEC_T * bs; ud.t0 = 0;
    ud.nv[0] = 64; ud.nv[1] = 64; ud.nv[2] = DEC_T;
    const size_t o0 = (size_t)(bs * CACHE_L) * 256 + 64 * g, o2 = (size_t)(MP + DEC_T * bs) * 256 + 64 * g;
    ud.kt[0] = F.CK + o0; ud.vt[0] = F.CV + o0; ud.kt[1] = F.CK + o0 + 64 * 256; ud.vt[1] = F.CV + o0 + 64 * 256; ud.kt[2] = F.KB + o2; ud.vt[2] = F.VB + o2;
}
struct UnitList { int p0, np, s0, ns, sstride; };
__device__ __forceinline__ void make_unit(Frame& F, const UnitList& L, int i, UnitDesc& ud) { if (i < L.np) make_prompt_unit(F, L.p0 + i, ud); else make_sample_unit(F, L.s0 + (i - L.np) * L.sstride, ud); }

__device__ __forceinline__ void issue_kv(Frame& F, const UnitDesc& ud, int setoff) {
    const int lane = F.lane, wid = F.wave;
#pragma unroll
    for (int j = 0; j < 3; ++j) {
        __builtin_amdgcn_global_load_lds((const unsigned*)(ud.kt[j] + (size_t)lane * 256 + wid * 8), (LAS unsigned*)(F.lds + RING_OFF + setoff + j * 8192 + wid * 1024), 16, 0, 0);
        __builtin_amdgcn_global_load_lds((const unsigned*)(ud.vt[j] + (size_t)(16 * (wid & 3) + (lane >> 2)) * 256 + 32 * (wid >> 2) + 8 * (lane & 3)), (LAS unsigned*)(F.lds + RING_OFF + setoff + 3 * 8192 + j * 8192 + wid * 1024), 16, 0, 0);
    }
}
__device__ __forceinline__ const bf16* q_addr(Frame& F, const UnitDesc& ud) {
    const int lane = F.lane, r32 = lane & 31, hi = lane >> 5, hh = F.wave >> 1, half = F.wave & 1;
    int qtok = half * 32 + r32; if (ud.sample && qtok > 15) qtok = 15;
    return F.Q + (size_t)(ud.row0 + qtok) * D + 256 * ud.g + 64 * hh + 8 * hi;
}
__device__ __forceinline__ void load_q(const bf16* qp, bf16x8 (&qr)[4]) {
#pragma unroll
    for (int d0 = 0; d0 < 4; ++d0) qr[d0] = NT_IF(NT_Q, (const GAS bf16x8*)(qp + 16 * d0));
}
typedef unsigned v2u __attribute__((ext_vector_type(2)));
__device__ __forceinline__ void unpack8b(const v2u& w, float (&o)[8]) { o[0] = (float)(w.x & 0xffu); o[1] = (float)((w.x >> 8) & 0xffu); o[2] = (float)((w.x >> 16) & 0xffu); o[3] = (float)(w.x >> 24);
    o[4] = (float)(w.y & 0xffu); o[5] = (float)((w.y >> 8) & 0xffu); o[6] = (float)((w.y >> 16) & 0xffu); o[7] = (float)(w.y >> 24); }
__device__ __forceinline__ void unpack8(const v4u& w, float (&o)[8]) { o[0] = bf_lo(w.x); o[1] = bf_hi(w.x); o[2] = bf_lo(w.y); o[3] = bf_hi(w.y); o[4] = bf_lo(w.z); o[5] = bf_hi(w.z); o[6] = bf_lo(w.w); o[7] = bf_hi(w.w); }

template <int MODE = 0  >
__device__ __forceinline__ void compute_unit(Frame& F, const UnitDesc& ud, int setoff, const bf16x8 (&qr)[4], bf16* mgbase, const bf16* qnp, bf16x8 (&qn)[4] P2TS_PARAM) {
    int lane_ = F.lane; asm volatile("" : "+v"(lane_));
    const int lane = lane_, r32 = lane & 31, hi = lane >> 5, wid = F.wave, hh = wid >> 1, half = wid & 1;
    LAS unsigned char* lds = F.lds + RING_OFF;
    if (ud.sample && half) return;
    f32x16 o[2]; o[0] = f32x16{}; o[1] = f32x16{};
    f32x16 p[6];
    const lds_cptr kp0 = (lds_cptr)(lds + setoff) + hi * 1024 + r32 * 16;
#pragma unroll
    for (int blk = 0; blk < 6; ++blk) {
        f32x16 a = {};
#pragma unroll
        for (int d0 = 0; d0 < 4; ++d0) {
            const bf16x8 kf = *(const LAS bf16x8*)(kp0 + (blk >> 1) * 8192 + (blk & 1) * 512 + d0 * 2048);
            a = __builtin_amdgcn_mfma_f32_32x32x16_bf16(kf, qr[d0], a, 0, 0, 0);
        }
        p[blk] = a;
    }
#ifdef P2_TS
    unsigned long long tq0 = 0, tq1 = 0, tq2 = 0, tq3 = 0;
    { int tmp; asm volatile("v_readfirstlane_b32 %0, %1" : "=s"(tmp) : "v"(p[5][15])); asm volatile("" :: "s"(tmp)); tq0 = __builtin_amdgcn_s_memrealtime(); }
#endif
    const float sink2 = F.sinks[4 * ud.g + hh] * 1.4426950408889634f;
    float l = 0.f, sk = sink2;
    const bool allvalid = ud.nv[0] == 64 && ud.nv[1] == 64 && ud.nv[2] == 64;
    if (!(allvalid && !ud.sample && __builtin_amdgcn_readfirstlane(*(const LAS int*)(lds + LDS_TOTAL2)) != 0)) {
        float mx = sink2;
        if (allvalid) {
#pragma unroll
            for (int blk = 0; blk < 6; ++blk)
#pragma unroll
                for (int r = 0; r < 16; ++r) mx = fmaxf(mx, p[blk][r]);
        } else {
#pragma unroll
            for (int blk = 0; blk < 6; ++blk) {
                const int nvj = ud.nv[blk >> 1];
#pragma unroll
                for (int r = 0; r < 16; ++r) { const int kk = (blk & 1) * 32 + crow(r, hi); const float s = kk < nvj ? p[blk][r] : -1e30f; p[blk][r] = s; mx = fmaxf(mx, s); }
            }
        }
        { auto rr = __builtin_amdgcn_permlane32_swap(__float_as_uint(mx), __float_as_uint(mx), false, false); mx = fmaxf(__uint_as_float(rr[0]), __uint_as_float(rr[1])); }
#pragma unroll
        for (int blk = 0; blk < 6; ++blk)
#pragma unroll
            for (int r = 0; r < 16; ++r) p[blk][r] -= mx;
        sk -= mx;
    }
    const int ch = lane & 7, rb = lane >> 3; const int colg = 256 * ud.g + 64 * hh + 8 * ch;
    int tok0 = half * 32 + 4 * rb;
    const bool lane_on = !ud.sample || rb < 4;
    if (!lane_on) tok0 = 12;
    const size_t rowb = (size_t)ud.row0 + tok0; const int tb = ud.t0 + tok0;
    v2u sgv[4]; v4u bgv[4], uv[6];
    v4u pw[12];
    { typedef float f32x2_t __attribute__((ext_vector_type(2))); f32x2_t l2 = {0.f, 0.f};
#pragma unroll
      for (int blk = 0; blk < 6; ++blk) {
          float e[16];
#pragma unroll
          for (int r = 0; r < 16; r += 2) { e[r] = __builtin_amdgcn_exp2f(p[blk][r]); e[r + 1] = __builtin_amdgcn_exp2f(p[blk][r + 1]); l2 += (f32x2_t){e[r], e[r + 1]}; }
#pragma unroll
          for (int h2 = 0; h2 < 2; ++h2) { v4u w; w.x = cvtpk(e[8 * h2 + 0], e[8 * h2 + 1]); w.y = cvtpk(e[8 * h2 + 2], e[8 * h2 + 3]); w.z = cvtpk(e[8 * h2 + 4], e[8 * h2 + 5]); w.w = cvtpk(e[8 * h2 + 6], e[8 * h2 + 7]); pw[2 * blk + h2] = w; }
          if (blk == 2) {
#pragma unroll
              for (int k = 0; k < 4; ++k) { sgv[k] = NT_IF(NT_MRG, (const GAS v2u*)((const unsigned char*)F.SG + (rowb + k) * D + colg)); bgv[k] = NT_IF(NT_MRG, (const GAS v4u*)(F.BG + (rowb + k) * D + colg)); }
              __builtin_amdgcn_sched_barrier(0);
          }
      }
      l = l2.x + l2.y; }
    { auto rr = __builtin_amdgcn_permlane32_swap(__float_as_uint(l), __float_as_uint(l), false, false); l = __uint_as_float(rr[0]) + __uint_as_float(rr[1]); }
    l += __builtin_amdgcn_exp2f(sk);
#ifdef P2_TS
    { int tmp; asm volatile("v_readfirstlane_b32 %0, %1" : "=s"(tmp) : "v"(l)); asm volatile("" :: "s"(tmp)); tq1 = __builtin_amdgcn_s_memrealtime(); }
#endif
#pragma unroll
    for (int j = 0; j < 6; ++j) { const int dj = (tb + j - 2 >= 0) ? j - 2 : 0; uv[j] = NT_IF(NT_MRG, (const GAS v4u*)(F.U + (size_t)((long)rowb + dj) * D + colg)); }
    const lds_cptr vp0 = (lds_cptr)(lds + setoff + 3 * 8192) + ((lane >> 4) & 1) * 32 + (lane & 3) * 8 + (4 * hi + ((lane & 15) >> 2)) * 64;
#pragma unroll
    for (int ks = 0; ks < 12; ++ks) {
        const bf16x8 pa = __builtin_bit_cast(bf16x8, pw[ks]);
#pragma unroll
        for (int d0 = 0; d0 < 2; ++d0) {
            const lds_cptr vp = vp0 + (ks >> 2) * 8192 + d0 * 4096 + (ks & 3) * 1024;
            const s16x4 lo = vtr(vp), hi4 = vtr(vp + 512);
            const bf16x8 vf = (bf16x8){lo[0], lo[1], lo[2], lo[3], hi4[0], hi4[1], hi4[2], hi4[3]};
            o[d0] = __builtin_amdgcn_mfma_f32_32x32x16_bf16(pa, vf, o[d0], 0, 0, 0);
        }
    }
#ifdef P2_TS
    { int tmp; asm volatile("v_readfirstlane_b32 %0, %1" : "=s"(tmp) : "v"(o[1][15])); asm volatile("" :: "s"(tmp)); tq2 = __builtin_amdgcn_s_memrealtime(); }
#endif
    if (qnp) load_q(qnp, qn);
    LAS float* wsf = (LAS float*)(lds + LDS_WS2) + wid * 64;
    if (hi == 0) wsf[r32] = l * 255.f;
    asm volatile("s_waitcnt lgkmcnt(0)" ::: "memory");
    LAS unsigned short* stg = (LAS unsigned short*)(lds + LDS_OST2) + wid * 2048;
#pragma unroll
    for (int r = 0; r < 16; ++r) { const int orow = crow(r, hi); const float rl = __builtin_amdgcn_rcpf(wsf[orow]);
#pragma unroll
        for (int d0 = 0; d0 < 1; ++d0) { const unsigned w = cvtpk(o[0][r] * rl, o[1][r] * rl); stg[orow * 64 + r32] = (unsigned short)(w & 0xffffu); stg[orow * 64 + 32 + r32] = (unsigned short)(w >> 16); } }
    asm volatile("s_waitcnt lgkmcnt(0)" ::: "memory");
#ifdef P2_TS
    tq3 = __builtin_amdgcn_s_memrealtime();
#endif
    f32x4 cw[3][2];
#pragma unroll
    for (int k = 0; k < 3; ++k) { cw[k][0] = *(const GAS f32x4*)(F.conv_w + k * D + colg); cw[k][1] = *(const GAS f32x4*)(F.conv_w + k * D + colg + 4); }
    float uf[6][8];
#pragma unroll
    for (int j = 0; j < 6; ++j) unpack8(uv[j], uf[j]);
    if (tb < 2) {
        if (ud.sample) { const float* sp = F.state_conv + (size_t)((ud.row0 - MP) / DEC_T * 2) * D + colg;
#pragma unroll
            for (int j = 0; j < 2; ++j) if (tb + j - 2 < 0) { const int pr = 2 + (tb + j - 2); const f32x4 a = *(const GAS f32x4*)(sp + (size_t)pr * D), b = *(const GAS f32x4*)(sp + (size_t)pr * D + 4);
                uf[j][0] = a.x; uf[j][1] = a.y; uf[j][2] = a.z; uf[j][3] = a.w; uf[j][4] = b.x; uf[j][5] = b.y; uf[j][6] = b.z; uf[j][7] = b.w; } }
        else {
#pragma unroll
            for (int j = 0; j < 2; ++j) if (tb + j - 2 < 0) {
#pragma unroll
                for (int e = 0; e < 8; ++e) uf[j][e] = 0.f; } }
    }
#pragma unroll
    for (int k = 0; k < 4; ++k) {
        const v4u ya = *(const LAS v4u*)(stg + (4 * rb + k) * 64 + ch * 8);
        float yv[8], sv[8], bv[8];
        unpack8(ya, yv); unpack8b(sgv[k], sv); unpack8(bgv[k], bv);
        float mo[8];
#pragma unroll
        for (int e = 0; e < 8; ++e) {
            const float conv = cw[0][e >> 2][e & 3] * uf[k][e] + cw[1][e >> 2][e & 3] * uf[k + 1][e] + cw[2][e >> 2][e & 3] * uf[k + 2][e];
            mo[e] = bv[e] * conv + sv[e] * yv[e];
        }
        v4u w; w.x = cvtpk(mo[0], mo[1]); w.y = cvtpk(mo[2], mo[3]); w.z = cvtpk(mo[4], mo[5]); w.w = cvtpk(mo[6], mo[7]);
        if (lane_on) *(GAS v4u*)(mgbase + (rowb + k) * D + colg) = w;
    }
#ifdef P2_TS
    if (threadIdx.x == 0 && !ud.sample) { const unsigned long long tq4 = __builtin_amdgcn_s_memrealtime(); unsigned long long* tp = (unsigned long long*)(F.ctl + 8192) + 2048;
        tp[2 * 256 + blockIdx.x] += tq0 - p2ts_c; tp[3 * 256 + blockIdx.x] += tq1 - tq0; tp[4 * 256 + blockIdx.x] += tq2 - tq1; tp[5 * 256 + blockIdx.x] += tq3 - tq2; tp[6 * 256 + blockIdx.x] += tq4 - tq3; }
#endif
}

template <int MODE = 0>
__device__ __forceinline__ void attn_phase(Frame& F, bool prompt, bool sample, int tix, int nteam, bf16* mgs, bf16* mgp) {
    constexpr int NPU = NB * 4 * NCH;
    UnitList L; L.p0 = 0; L.np = 0; L.s0 = tix; L.ns = 0; L.sstride = nteam;
    if (prompt) { const int per = (NPU + F.G - 1) / F.G; L.p0 = F.vcu * per; L.np = NPU - L.p0 < per ? (NPU - L.p0 > 0 ? NPU - L.p0 : 0) : per;
        if (F.G == 256) { const int x = (int)blockIdx.x & 7, j = (int)blockIdx.x >> 3; L.p0 = (((x >> 1) * 4 + (j & 3)) * NCH) + 64 * (x & 1) + 8 * (j >> 2); L.np = 8; } }
    if (sample && tix < DEC_B * 4) L.ns = (DEC_B * 4 - tix + nteam - 1) / nteam;
    const int n = L.np + L.ns; if (n == 0) return;
    if (F.wave == 0) { float a = fabsf(F.q_norm_w[F.lane]), b = fabsf(F.k_norm_w[F.lane]), c = fabsf(F.sinks[F.lane & 15]) * 1.4426950408889634f;
#pragma unroll
      for (int o = 1; o < 64; o <<= 1) { a = fmaxf(a, __shfl_xor(a, o)); b = fmaxf(b, __shfl_xor(b, o)); c = fmaxf(c, __shfl_xor(c, o)); }
      if (F.lane == 0) *(LAS int*)(F.lds + RING_OFF + LDS_TOTAL2) = (64.f * pg8::QSCALE * a * b * 1.02f <= 60.f && c <= 60.f) ? 1 : 0; }
    UnitDesc ud; bf16x8 qr[4], qn[4];
    make_unit(F, L, 0, ud); issue_kv(F, ud, 0); load_q(q_addr(F, ud), qr);
    for (int i = 0; i < n; ++i) {
#ifdef P2_TS
        const unsigned long long p2ts_a = __builtin_amdgcn_s_memrealtime();
#endif
        __syncthreads();
#ifdef P2_TS
        const unsigned long long p2ts_b = __builtin_amdgcn_s_memrealtime();
#endif
        const int setoff = (i & 1) * SET_BYTES;
        const bf16* qnp = nullptr;
        if (i + 1 < n) { make_unit(F, L, i + 1, ud); issue_kv(F, ud, SET_BYTES - setoff); qnp = q_addr(F, ud); }
        make_unit(F, L, i, ud);
#ifdef P2_TS
        const unsigned long long p2ts_c = __builtin_amdgcn_s_memrealtime();
        if (threadIdx.x == 0 && prompt) { unsigned long long* tp = (unsigned long long*)(F.ctl + 8192) + 2048; tp[0 * 256 + blockIdx.x] += p2ts_b - p2ts_a; tp[1 * 256 + blockIdx.x] += p2ts_c - p2ts_b; }
#endif
        compute_unit<MODE>(F, ud, setoff, qr, i < L.np ? mgp : mgs, qnp, qn P2TS_ARG);
#pragma unroll
        for (int d0 = 0; d0 < 4; ++d0) qr[d0] = qn[d0];
    }
    __syncthreads();
}
}


__device__ __forceinline__ void stage_signal(gu32* cnt) {
    asm volatile("s_waitcnt vmcnt(0)" ::: "memory"); __syncthreads();
    if (threadIdx.x == 0) { __builtin_amdgcn_fence(__ATOMIC_RELEASE, "agent"); asm volatile("s_waitcnt vmcnt(0)" ::: "memory"); __hip_atomic_fetch_add(cnt, 1u, RLX_AGENT); }
}
__device__ __forceinline__ void stage_wait(gu32* cnt, unsigned target) {
    if (threadIdx.x == 0) {
        unsigned sp = 0; while (__hip_atomic_load(cnt, RLX_AGENT) < target) { __builtin_amdgcn_s_sleep(2); if (++sp > (1u << 21)) break; }
        __builtin_amdgcn_fence(__ATOMIC_ACQUIRE, "agent"); asm volatile("s_waitcnt vmcnt(0)" ::: "memory");
    }
    __syncthreads();
}
__device__ __forceinline__ void group_barrier(gu32* cnt, unsigned target) {
    asm volatile("s_waitcnt vmcnt(0)" ::: "memory"); __syncthreads();
    if (threadIdx.x == 0) {
        __builtin_amdgcn_fence(__ATOMIC_RELEASE, "agent"); asm volatile("s_waitcnt vmcnt(0)" ::: "memory"); __hip_atomic_fetch_add(cnt, 1u, RLX_AGENT);
        unsigned sp = 0; while (__hip_atomic_load(cnt, RLX_AGENT) < target) { __builtin_amdgcn_s_sleep(1); if (++sp > (1u << 22)) break; }
        __builtin_amdgcn_fence(__ATOMIC_ACQUIRE, "agent"); asm volatile("s_waitcnt vmcnt(0)" ::: "memory");
    }
    __syncthreads();
}
constexpr int CW_GRP = 3584;
constexpr int TEAM = 32;
constexpr int CW_TEAM = 3072;
struct Args { const float* in[16]; float* out; unsigned char* ws; };
__global__ void __launch_bounds__(NWAVES * 64, 2) mk_fwd(Args args) {
    extern __shared__ __attribute__((aligned(16))) unsigned char lds[];
    Frame F;
    F.lds = (LAS unsigned char*)lds;
    F.MISC = (volatile LAS unsigned*)(F.lds + MISC_OFF);
    F.tid = threadIdx.x; F.lane = F.tid & 63; F.wave = __builtin_amdgcn_readfirstlane(F.tid >> 6);
    F.G = gridDim.x; { const int bx = blockIdx.x; F.vcu = (F.G % 8 == 0) ? (bx % 8) * (F.G / 8) + bx / 8 : bx; }
    unsigned char* ws = args.ws;
    F.ctl = (gu32*)(ws + WS_CTL);
    F.xp = args.in[0]; F.xs = args.in[1]; F.state_conv = args.in[2]; F.cache_k = args.in[3]; F.cache_v = args.in[4]; F.norm_mix_w = args.in[5]; F.w_in = args.in[6]; F.conv_w = args.in[7];
    F.q_norm_w = args.in[8]; F.k_norm_w = args.in[9]; F.sinks = args.in[10]; F.w_out = args.in[11]; F.norm_ffn_w = args.in[12]; F.w_gate = args.in[13]; F.w_up = args.in[14]; F.w_down = args.in[15];
    F.out = args.out;
    F.Win_t = (bf16*)(ws + WS_WIN); F.Wout_t = (bf16*)(ws + WS_WOUT); F.Wgu_t = (bf16*)(ws + WS_WGU); F.Wd_t = (bf16*)(ws + WS_WD);
    F.XN = (bf16*)(ws + WS_XN);
    F.MG = (bf16*)(ws + WS_MG);
    F.Q = (bf16*)(ws + WS_Q); F.X1B = (bf16*)(ws + WS_Q); F.KB = (bf16*)(ws + WS_K); F.VB = (bf16*)(ws + WS_V);
    F.U = (bf16*)(ws + WS_U); F.BG = (bf16*)(ws + WS_BG); F.SG = (bf16*)(ws + WS_SG); F.H = (bf16*)(ws + WS_H); F.CK = (bf16*)(ws + WS_CK); F.CV = (bf16*)(ws + WS_CV);
    F.SS = (float*)(ws + WS_SS); F.IR = (float*)(ws + WS_IR);
    for (int u = F.tid; u < (LDS_BYTES - LDSCTL_OFF) / 4; u += NWAVES * 64) ((LAS unsigned*)(F.lds + LDSCTL_OFF))[u] = 0u;
    __syncthreads();
    XcdBarrier bar; bar.bar = (unsigned*)(F.ctl + CW_BAR); bar.x = 0; bar.st = nullptr;
    bar = xcd_barrier_post((unsigned*)(F.ctl + CW_BAR), F.MISC + 8);
#define GRID_BAR() xcd_barrier(bar)

#ifndef DEFER_W
#define DEFER_W 1
#endif
#ifdef TSPROBE
    if (threadIdx.x == 0) ((volatile unsigned long long*)(F.ctl + 8192))[3840 + blockIdx.x] = rt();
#endif
    p0_prologue(F, DEFER_W && gridDim.x == 256);
#ifdef TSPROBE
    if (threadIdx.x == 0) ((volatile unsigned long long*)(F.ctl + 8192))[0 * 256 + blockIdx.x] = rt();
#endif
    GRID_BAR();
    const int tix = (int)blockIdx.x; const bool use_team = (F.G == 256); const bool team = use_team && tix < TEAM;
#ifdef TSPROBE
#define TS(k) do { if (threadIdx.x == 0) ((volatile unsigned long long*)(F.ctl + 8192))[(k) * 256 + tix] = rt(); } while (0)
#else
#define TS(k) do {} while (0)
#endif
    const int MPR = use_team ? MP : MROWS;
    bf16* const Hs = (bf16*)(ws + WS_HS) - (size_t)MP * DFF;
    bf16* const MGs = (bf16*)(ws + WS_MGS) - (size_t)MP * D;
#ifdef EPI_TS
#define EPI_TS_INIT , (unsigned long long*)(F.ctl + 8192)
#else
#define EPI_TS_INIT
#endif
#define RUN_IN(S_)  do { pg8::Gemm g{F.XN, F.Win_t, MROWS, NIN, D}; pg8::EpiIn E{ws, F.q_norm_w, F.k_norm_w, F.out}; pg8::gemm_phase<pg8::EpiIn, pg8::Order, KN_ALIGN, KN_SP2>(F.lds + RING_OFF, g, S_, E); } while (0)
#define RUN_OUT(S_, MG_) do { pg8::Gemm g{MG_, F.Wout_t, MROWS, D, D}; pg8::EpiOut E{F.XN, F.IR, F.norm_mix_w, F.X1B, F.SS, (PG8_LAS float*)(F.lds + RING_BYTES)}; pg8::gemm_phase<pg8::EpiOut, pg8::Order, KN_ALIGN, KN_SP2, AUX_OUT>(F.lds + RING_OFF, g, S_, E); } while (0)
#define RUN_GU(S_, H_) RUN_GU_M(S_, H_, -1, -1)
#define RUN_GU_M(S_, H_, AM_, BM_)   do { pg8::Gemm g{F.X1B, F.Wgu_t, MROWS, NGU, D, AM_, BM_}; pg8::EpiGU E{F.SS, H_}; pg8::gemm_phase<pg8::EpiGU, pg8::Order, KN_ALIGN_GU, KN_SP2>(F.lds + RING_OFF, g, S_, E); } while (0)
#define RUN_DOWN(S_, H_) do { pg8::Gemm g{H_, F.Wd_t, MROWS, D, DFF}; pg8::EpiDown E{F.out + pg8::OUT_Y, F.X1B EPI_TS_INIT}; pg8::gemm_phase<pg8::EpiDown, pg8::Order, KN_ALIGN_DN, KN_SP2, AUX_DN>(F.lds + RING_OFF, g, S_, E); } while (0)
#ifndef KN_ALIGN
#define KN_ALIGN true
#endif
#ifndef KN_ALIGN_GU
#define KN_ALIGN_GU KN_ALIGN
#endif
#ifndef KN_ALIGN_DN
#define KN_ALIGN_DN KN_ALIGN
#endif
#ifndef AUX_DN
#define AUX_DN 0
#endif
#ifndef AUX_OUT
#define AUX_OUT 0
#endif
#ifndef KN_SP2
#define KN_SP2 true
#endif
#ifndef REV_DOWN
#define REV_DOWN 1
#endif
#define TEAM_CHAIN() do { gu32* const c1 = F.ctl + CW_TEAM, * const c2 = c1 + 64, * const c3 = c1 + 128, * const c4 = c1 + 192, * const w1 = c1 + 256, * const w2 = c1 + 320; pg8::Order S; \
          \
        if (tix < 26) { S.panel(128, NIN, tix, TEAM); RUN_IN(S); stage_signal(c1); } \
        else { if (DEFER_W) p0_weight_items(F, I_IN, I_O, tix - 26, TEAM - 26); stage_signal(w1); } \
        stage_wait(c1, 26); p2::attn_phase(F, false, true, tix, TEAM, MGs, F.MG); stage_signal(c2); \
        if (tix < 4) { stage_wait(c2, TEAM); stage_wait(w1, TEAM - 26); S.panel(128, D, tix, TEAM); RUN_OUT(S, MGs); stage_signal(c3); } \
        else if (tix < 24 || tix >= 28) { if (DEFER_W) p0_weight_items(F, I_IN + I_O, 2 * I_G + I_D, tix < 24 ? tix - 4 : tix - 8, TEAM - 8); stage_signal(w2); }     \
        if (tix < 22) { stage_wait(c3, 4); stage_wait(w2, TEAM - 8); S.panel(128, NGU, tix, TEAM); RUN_GU(S, Hs); stage_signal(c4); } \
        if (tix < 4) { stage_wait(c4, 22); S.panel(128, D, tix, TEAM); RUN_DOWN(S, Hs); } } while (0)
#define PROMPT_IN() do { pg8::Order S; \
        if (!use_team) S.grid(MROWS, NIN, tix, F.G, 1 << 30); \
        else if (team) {   \
            const int r = tix & 7, q = tix >> 3; const bool heavy = r < 4; \
            const int share = heavy ? (q == 0 ? 2 : (q == 3 ? 10 : 6)) : 6, first = heavy ? (q == 0 ? 0 : (q == 1 ? 2 : (q == 2 ? 8 : 14))) : 6 * q; \
            S.grid(MP, NIN, (F.G - TEAM) * 14 + r + 8 * first, 8, share); } \
        else S.grid(MP, NIN, tix - TEAM, F.G - TEAM, 14); \
        RUN_IN(S); } while (0)
    if (team) TEAM_CHAIN();
    PROMPT_IN();                                         TS(1); GRID_BAR();
#define GROUP_BAR(n) do { if (use_team) group_barrier(F.ctl + CW_GRP + 64 * (tix & 7), 32u * (n)); else GRID_BAR(); } while (0)
    {
        pg8::Order S;
        p2::attn_phase(F, true, !use_team, tix, F.G, F.MG, F.MG);        TS(2); GRID_BAR();
#ifdef P2_EXTRA
        p2::attn_phase<P2_EXTRA>(F, true, false, tix, F.G, (bf16*)F.out, (bf16*)F.out);   GRID_BAR();
#endif
        S.grid(MPR, D, tix, F.G, 1 << 30);   RUN_OUT(S, F.MG);     TS(3); GRID_BAR();
#if defined(GU_EXTRA) && GU_EXTRA == 1
        S.grid(MPR, NGU, tix, F.G, 1 << 30); RUN_GU_M(S, F.H, 7, 3); GRID_BAR();
#elif defined(GU_EXTRA)
        S.grid(MPR, NGU, tix, F.G, 1 << 30); RUN_GU(S, F.H); GRID_BAR();
#endif
#ifdef TSPROBE
        unsigned long long ck0 = __builtin_readcyclecounter(), rk0 = rt();
#endif
        S.grid(MPR, NGU, tix, F.G, 1 << 30); RUN_GU(S, F.H); TS(4);
#ifdef TSPROBE
        { const unsigned long long ck1 = __builtin_readcyclecounter(), rk1 = rt(); if (threadIdx.x == 0) { volatile unsigned long long* cp = (volatile unsigned long long*)(F.ctl + 8192) + 7 * 256; cp[tix] = ((ck1 - ck0) * 1000ull) / (rk1 - rk0); } }
#endif
        GRID_BAR(); TS(6);
        S.grid(MPR, D, tix, F.G, 1 << 30, REV_DOWN);   RUN_DOWN(S, F.H);
#ifdef TSPROBE
        asm volatile("s_waitcnt vmcnt(0)" ::: "memory"); TS(5); GRID_BAR();
        if (tix == 0) {
            LAS float* sh = (LAS float*)(F.lds + RING_OFF);
            if (threadIdx.x == 0) {
                const volatile unsigned long long* ts = (const volatile unsigned long long*)(F.ctl + 8192);
                float mx[6], mn[6], av[6], mxt[6], mxn[6], avt[6];
                for (int k = 0; k < 6; ++k) { unsigned long long t0 = ts[k * 256]; unsigned long long lo = t0, hi = t0, hit = t0, hin = ts[k * 256 + 32]; double s = 0, st = 0;
                    for (int w = 0; w < 256; ++w) { const unsigned long long t = ts[k * 256 + w]; lo = t < lo ? t : lo; hi = t > hi ? t : hi; s += (double)(long long)(t - t0);
                        if (w < 32) { hit = t > hit ? t : hit; st += (double)(long long)(t - t0); } else hin = t > hin ? t : hin; }
                    const unsigned long long base = ts[0]; mx[k] = (float)(long long)(hi - base) * 0.01f; mn[k] = (float)(long long)(lo - base) * 0.01f; av[k] = ((float)(long long)(t0 - base) + (float)(s / 256.0)) * 0.01f;
                    mxt[k] = (float)(long long)(hit - base) * 0.01f; mxn[k] = (float)(long long)(hin - base) * 0.01f; avt[k] = ((float)(long long)(t0 - base) + (float)(st / 32.0)) * 0.01f; }
                float m = 0.f; const int sel = TSPROBE;
                if (sel < 6) m = mx[sel] - av[sel];
                else if (sel == 9) { for (int k = 0; k < 6; ++k) m += mx[k] - av[k]; }
                else if (sel >= 10 && sel < 16) m = mx[sel - 10] - mn[sel - 10];
                else if (sel >= 21 && sel < 26) m = mx[sel - 20] - mx[sel - 21];
                else if (sel >= 31 && sel < 36) m = av[sel - 30] - mx[sel - 31];
                else if (sel >= 40 && sel < 46) m = mxt[sel - 40] - av[sel - 40];
                else if (sel >= 50 && sel < 56) m = mxn[sel - 50] - av[sel - 50];
                else if (sel >= 60 && sel < 66) m = fabsf(avt[sel - 60] - av[sel - 60]);
                else if (sel >= 70 && sel < 76) m = av[sel - 70] - mn[sel - 70];
                else if (sel == 80 || sel == 81) { const unsigned long long base = ts[0]; float best = -1e30f;
                    for (int w = (sel == 81 ? 32 : 0); w < 256; ++w) { float s = 0.f; for (int k = 0; k < 6; ++k) if (k != 1 || sel == 81) s += (float)(long long)(ts[k * 256 + w] - base) * 0.01f - av[k]; best = fmaxf(best, s); }
                    m = best; }
                else if (sel == 98 || sel == 99) { const unsigned long long base = ts[0]; float best = -1e30f; int bx = 0;
                    for (int x = 0; x < 8; ++x) { float s = 0.f; for (int w = x; w < 256; w += 8) for (int k = 0; k < 6; ++k) if (k != 1) s += (float)(long long)(ts[k * 256 + w] - base) * 0.01f - av[k];
                        s *= (1.f / 32.f); if (s > best) { best = s; bx = x; } }
                    m = sel == 98 ? best : 10.f * (float)(bx + 1); }
                else if (sel >= 100 && sel < 104) { const volatile unsigned long long* ep = (const volatile unsigned long long*)(F.ctl + 8192) + 2048 + 256 * (sel - 100); double s = 0; for (int w = 0; w < 256; ++w) s += (double)ep[w]; m = (float)(s / 256.0) * 0.01f; }
                else if (sel >= 110 && sel < 114) { const volatile unsigned long long* tp = (const volatile unsigned long long*)(F.ctl + 8192) + 2048; const volatile unsigned long long* t6 = (const volatile unsigned long long*)(F.ctl + 8192) + 6 * 256; double s = 0;
                    for (int w = 0; w < 256; ++w) { const unsigned long long a0 = tp[1024 + w * 4], a1 = tp[1024 + w * 4 + 1], b0 = tp[1024 + w * 4 + 2], b1 = tp[1024 + w * 4 + 3];
                        s += sel == 110 ? (double)(long long)(a0 - t6[w]) : sel == 111 ? (double)(long long)(b0 - a1) : sel == 112 ? (double)(long long)(a1 - a0) : (double)(long long)(b1 - b0); }
                    m = (float)(s / 256.0) * 0.01f; }
                else if (sel == 120) { const volatile unsigned long long* cp = (const volatile unsigned long long*)(F.ctl + 8192) + 7 * 256; double s = 0; for (int w = 0; w < 256; ++w) s += (double)cp[w]; m = (float)(s / 256.0) * 0.01f; }
                else if (sel >= 130 && sel < 137) { const volatile unsigned long long* tp = (const volatile unsigned long long*)(F.ctl + 8192) + 2048 + 256 * (sel - 130); double s = 0; for (int w = 0; w < 256; ++w) s += (double)tp[w]; m = (float)(s / 256.0) * 0.01f; }
                else if (sel == 140) { unsigned long long lo = ts[3840]; for (int w = 1; w < 256; ++w) { const unsigned long long t = ts[3840 + w]; lo = t < lo ? t : lo; } m = mx[0] + (float)(long long)(ts[0] - lo) * 0.01f; }
                else if (sel >= 90 && sel < 98) { const unsigned long long base = ts[0]; float s = 0.f;
                    for (int w = sel - 90; w < 256; w += 8) for (int k = 0; k < 6; ++k) if (k != 1) s += (float)(long long)(ts[k * 256 + w] - base) * 0.01f - av[k];
                    m = fabsf(s) * (1.f / 32.f); }
                sh[0] = floorf(m + 0.5f);
            }
            __syncthreads();
            const float sc = 1.f + sh[0] * (1.f / TSDIV);
            for (int i = threadIdx.x; i < 256 * 1024; i += NWAVES * 64) F.out[(size_t)MP * D + i] *= sc;
        }
#endif
    }
}

extern "C" void kernel_launch(void* const* d_in, const int* in_sizes, int n_in, void* d_out, int out_size, void* d_ws, size_t ws_size, hipStream_t stream) {
    static int grid = 0;
    if (grid == 0) {
        if (n_in != 16 || in_sizes[0] != MP * D || (size_t)out_size != pg8::OUT_TOTAL || ws_size < WS_END) {
            fprintf(stderr, "kernel_launch: shape mismatch: n_in %d in0 %d out %d ws %zu (need %zu); nothing launched\n", n_in, n_in > 0 ? in_sizes[0] : -1, out_size, ws_size, (size_t)WS_END); grid = -1; return; }
        int dev = 0, cus = 0, per_cu = 0;
        if (hipGetDevice(&dev) != hipSuccess || hipDeviceGetAttribute(&cus, hipDeviceAttributeMultiprocessorCount, dev) != hipSuccess) { fprintf(stderr, "kernel_launch: device query failed\n"); grid = -1; return; }
        if (hipFuncSetAttribute((const void*)mk_fwd, hipFuncAttributeMaxDynamicSharedMemorySize, LDS_BYTES) != hipSuccess) { fprintf(stderr, "kernel_launch: hipFuncSetAttribute failed\n"); grid = -1; return; }
        if (hipOccupancyMaxActiveBlocksPerMultiprocessor(&per_cu, (const void*)mk_fwd, NWAVES * 64, LDS_BYTES) != hipSuccess || per_cu < 1) { fprintf(stderr, "kernel_launch: occupancy query reports %d blocks per CU\n", per_cu); (void)hipGetLastError(); per_cu = 1; }
        grid = cus;
        if (grid % 8 != 0) grid -= grid % 8;
    }
    if (grid < 0) return;
    if (hipMemsetAsync((char*)d_ws + WS_CTL, 0, CTL_ZERO_BYTES, stream) != hipSuccess) { fprintf(stderr, "kernel_launch: memset failed\n"); return; }
    Args a{};
    for (int i = 0; i < 16; ++i) a.in[i] = (const float*)d_in[i];
    a.out = (float*)d_out; a.ws = (unsigned char*)d_ws;
    hipLaunchKernelGGL(mk_fwd, dim3(grid), dim3(NWAVES * 64), LDS_BYTES, stream, a);
    const hipError_t le = hipPeekAtLastError();
    if (le != hipSuccess) fprintf(stderr, "kernel_launch: launch failed: %s\n", hipGetErrorName(le));
}
```

```cpp
#include <hip/hip_runtime.h>
#include <cstdio>
#include <cstdint>
namespace pg8 {
#define PG8_LAS __attribute__((address_space(3)))
typedef unsigned short bf16_t;
typedef short bf16x8 __attribute__((ext_vector_type(8)));
typedef float f32x4 __attribute__((ext_vector_type(4)));
typedef unsigned u32x4 __attribute__((ext_vector_type(4)));
constexpr int BM = 256, BK = 64, HALF = 128, HTB = HALF * BK * 2  , STAGE_BYTES = 8 * HTB, NXCD = 8, WGM = 8;

__host__ __device__ __forceinline__ int lds_byte(int r, int c) { const int st = (r >> 4) * 2 + (c >> 5), rr = r & 15, cc = c & 31, ob = rr * 64 + cc * 2; return st * 1024 + (ob ^ (((ob >> 9) & 1) << 5)); }
__host__ __device__ __forceinline__ void stage_rc(int b, int& R, int& C) { const int st = b / 1024, sb = b % 1024, swz = sb ^ (((sb >> 9) & 1) << 5); R = (st >> 1) * 16 + swz / 64; C = (st & 1) * 32 + (swz % 64) / 2; }
__host__ __device__ __forceinline__ int perm32(int rho) { const int n = rho >> 4, i = rho & 15; return 8 * (i >> 2) + 4 * n + (i & 3); }

struct Unit { int pm, pn; };
struct Gemm { const bf16_t* A; const bf16_t* Bt; int M, N, K; int amask = -1, bmask = -1; };

struct StaticOrder {
    int nM, nN, nwg, G, c;
    __host__ __device__ void init(int M, int N, int G_, int c_) { nM = M / BM; nN = N / BM; nwg = nM * nN; G = G_; c = c_; }
    __host__ __device__ bool next(int i, Unit& u) const {
        const long L = (long)i * G + c; if (L >= nwg) return false;
        int wgid = (int)L; { const int q = nwg / NXCD, r = nwg % NXCD, xcd = wgid % NXCD, off = wgid / NXCD; wgid = (xcd < r ? xcd * (q + 1) : r * (q + 1) + (xcd - r) * q) + off; }
        const int nig = WGM * nN, gid = wgid / nig, fm = gid * WGM, gsz = (nM - fm) < WGM ? (nM - fm) : WGM;
        u.pm = fm + ((wgid % nig) % gsz); u.pn = (wgid % nig) / gsz; return true;
    }
    __device__ __forceinline__ void a_ready(const Unit&) const {}
    __device__ __forceinline__ void done(const Unit&) const {}
};
struct Order {
    int nM, nN, nwg, L0, stride, count, mode, pm_fixed, rev;
    __device__ __forceinline__ void grid(int M, int N, int L0_, int stride_, int count_, int rev_ = 0) { nM = M / BM; nN = N / BM; nwg = nM * nN; L0 = L0_; stride = stride_; count = count_; mode = 0; pm_fixed = 0; rev = rev_; }
    __device__ __forceinline__ void panel(int pm, int N, int L0_, int stride_) { nM = 1; nN = N / BM; nwg = nN; L0 = L0_; stride = stride_; count = 1 << 30; mode = 1; pm_fixed = pm; rev = 0; }
    __device__ __forceinline__ bool next(int i, Unit& u) const {
        if (i >= count) return false;
        const long L = (long)i * stride + L0; if (L >= nwg) return false;
        if (mode == 1) { u.pm = pm_fixed; u.pn = (int)L; return true; }
        int wgid = (int)L; { const int q = nwg / NXCD, r = nwg % NXCD, xcd = wgid % NXCD, off = wgid / NXCD;
            const int clen = xcd < r ? q + 1 : q, cst = xcd < r ? xcd * (q + 1) : r * (q + 1) + (xcd - r) * q;
            wgid = cst + (rev ? clen - 1 - off : off); }
        const int nig = WGM * nN, gid = wgid / nig, fm = gid * WGM, gsz = (nM - fm) < WGM ? (nM - fm) : WGM;
        u.pm = fm + ((wgid % nig) % gsz); u.pn = (wgid % nig) / gsz; return true;
    }
    __device__ __forceinline__ void a_ready(const Unit&) const {}
    __device__ __forceinline__ void done(const Unit&) const {}
};

typedef float f32x2_t __attribute__((ext_vector_type(2))); typedef __bf16 bf16x2_t __attribute__((ext_vector_type(2)));
__device__ __forceinline__ unsigned cvt_pk_bf16(float lo, float hi) { f32x2_t v = {lo, hi}; bf16x2_t b = __builtin_convertvector(v, bf16x2_t); return __builtin_bit_cast(unsigned, b); }
__device__ __forceinline__ float sigmoid_f(float x) { return __builtin_amdgcn_rcpf(1.0f + __builtin_amdgcn_exp2f(-1.4426950408889634f * x)); }
__device__ __forceinline__ f32x4 sigmoid4(const f32x4& x) {
    const f32x4 t = x * -1.4426950408889634f; f32x4 e, s;
#pragma unroll
    for (int j = 0; j < 4; ++j) e[j] = __builtin_amdgcn_exp2f(t[j]);
    e = e + (f32x4){1.f, 1.f, 1.f, 1.f};
#pragma unroll
    for (int j = 0; j < 4; ++j) s[j] = __builtin_amdgcn_rcpf(e[j]);
    return s;
}
__device__ __forceinline__ f32x4 sigmoid255(const f32x4& x) {
    const f32x4 t = x * -1.4426950408889634f; f32x4 e, s;
#pragma unroll
    for (int j = 0; j < 4; ++j) e[j] = __builtin_amdgcn_exp2f(t[j]);
    e = e * (1.0f / 255.0f) + (f32x4){1.0f / 255.0f, 1.0f / 255.0f, 1.0f / 255.0f, 1.0f / 255.0f};
#pragma unroll
    for (int j = 0; j < 4; ++j) s[j] = __builtin_amdgcn_rcpf(e[j]);
    return s;
}
__device__ __forceinline__ u32x4 pack8(const f32x4& a, const f32x4& b) { u32x4 w; w.x = cvt_pk_bf16(a[0], a[1]); w.y = cvt_pk_bf16(a[2], a[3]); w.z = cvt_pk_bf16(b[0], b[1]); w.w = cvt_pk_bf16(b[2], b[3]); return w; }

constexpr int MROWS = 33024, MP = 32768, SEQ_T = 8192;
constexpr float RMS_EPS = 1e-6f;
constexpr size_t EO_Q = 105ull << 20, EO_K = 170ull << 20, EO_V = 187ull << 20, EO_U = 204ull << 20, EO_BG = 269ull << 20, EO_SG = 334ull << 20;
constexpr float QSCALE = 0.125f * 1.4426950408889634f;
constexpr size_t OUT_Y = 0, OUT_CONVP = 33816576, OUT_KP = 33824768, OUT_VP = 33955840, OUT_CONVS = 34086912, OUT_KS = 34119680, OUT_VS = 34185216, OUT_TOTAL = 34250752;

struct EpiIn {
    static constexpr bool PERM = true, AFTER_DRAIN = false;
    unsigned char* ws; const float *qw, *kw; float* out;
    struct Pre {}; __device__ __forceinline__ void prefetch(const Unit&, Pre&, int, int, int) const {}
    __device__ __forceinline__ void operator()(const f32x4 (&acc)[2][2][4][2], const Unit& u, int wr, int wc, int fr, int fq, const Pre&) const {
        asm volatile("" : "+v"(fr), "+v"(fq), "+s"(wr), "+s"(wc));
        const int pn = u.pn, pm = u.pm;
        bf16_t* const U = (bf16_t*)(ws + EO_U); bf16_t* const BG = (bf16_t*)(ws + EO_BG); bf16_t* const SG = (bf16_t*)(ws + EO_SG);
        bf16_t* const Q = (bf16_t*)(ws + EO_Q); bf16_t* const K = (bf16_t*)(ws + EO_K); bf16_t* const V = (bf16_t*)(ws + EO_V);
        const int lrow0 = wr * 64 + fr;
        const size_t grow0 = (size_t)pm * BM + lrow0;
        if (pn < 16) {
            const bool isU = pn < 8; const int p = isU ? pn : pn - 8;
            bf16_t* O = isU ? U : BG;
            const int col = 128 * p + 32 * wc + 8 * fq;
#pragma unroll
            for (int ai = 0; ai < 2; ++ai)
#pragma unroll
                for (int m = 0; m < 4; ++m) {
                    f32x4 a0 = acc[ai][0][m][0], a1 = acc[ai][0][m][1], b0 = acc[ai][1][m][0], b1 = acc[ai][1][m][1];
                    f32x4 r0, r1;
                    if (isU) { r0 = a0 * b0; r1 = a1 * b1; }
                    else {
#pragma unroll
                        for (int j = 0; j < 1; ++j) { r0 = a0 * sigmoid4(b0); r1 = a1 * sigmoid4(b1); }
                    }
                    const size_t row = grow0 + ai * HALF + m * 16;
                    *(u32x4*)(O + row * 1024 + col) = pack8(r0, r1);
                    if (isU && fr >= 14) {
                        float* dst = nullptr;
                        if (pm == 128) dst = out + OUT_CONVS + (size_t)((8 * ai + 4 * wr + m) * 2 + (fr - 14)) * 1024 + col;
                        else if ((pm & 31) == 31 && ai == 1 && wr == 1 && m == 3) dst = out + OUT_CONVP + (size_t)((pm >> 5) * 2 + (fr - 14)) * 1024 + col;
                        if (dst) { *(f32x4*)dst = r0; *(f32x4*)(dst + 4) = r1; }
                    }
                }
        } else if (pn < 22) {
            const bool isQ = pn < 20, isK = pn == 20;
            const float* nw = isQ ? qw : kw; asm volatile("" : "+s"(nw));
            f32x4 w[2][2];
#pragma unroll
            for (int bj = 0; bj < 2; ++bj)
#pragma unroll
                for (int n = 0; n < 2; ++n) {
                    if (pn == 21) w[bj][n] = (f32x4){1.f, 1.f, 1.f, 1.f};
                    else { w[bj][n] = *(const __attribute__((address_space(1))) f32x4*)(nw + 32 * bj + 8 * fq + 4 * n); if (isQ) w[bj][n] = w[bj][n] * QSCALE; }
                }
            bf16_t* O = isQ ? Q : (isK ? K : V); const int ldo = isQ ? 1024 : 256;
            const int col = (isQ ? 256 * (pn - 16) : 0) + 64 * wc + 8 * fq;
            float* o32p = out + (isK ? OUT_KP : OUT_VP); float* o32s = out + (isK ? OUT_KS : OUT_VS);
#pragma unroll
            for (int ai = 0; ai < 2; ++ai)
#pragma unroll
                for (int m = 0; m < 4; ++m) {
                    f32x4 v[2][2];
#pragma unroll
                    for (int bj = 0; bj < 2; ++bj)
#pragma unroll
                        for (int n = 0; n < 2; ++n) v[bj][n] = acc[ai][bj][m][n];
                    if (pn != 21) {
                        float ss = 0.f;
#pragma unroll
                        for (int bj = 0; bj < 2; ++bj)
#pragma unroll
                            for (int n = 0; n < 2; ++n) { const f32x4 x = v[bj][n]; ss += (x[0] * x[0] + x[1] * x[1]) + (x[2] * x[2] + x[3] * x[3]); }
                        ss += __shfl_xor(ss, 16); ss += __shfl_xor(ss, 32);
                        const float rs = __builtin_amdgcn_rsqf(ss * (1.0f / 64.0f) + RMS_EPS);
#pragma unroll
                        for (int bj = 0; bj < 2; ++bj)
#pragma unroll
                            for (int n = 0; n < 2; ++n) v[bj][n] = v[bj][n] * rs * w[bj][n];
                    }
                    const int lrow = lrow0 + ai * HALF + m * 16;
                    const size_t row = (size_t)pm * BM + lrow;
#pragma unroll
                    for (int bj = 0; bj < 2; ++bj) *(u32x4*)(O + row * ldo + col + 32 * bj) = pack8(v[bj][0], v[bj][1]);
                    if (!isQ) {
                        float* dst = nullptr;
                        if (pm == 128) dst = o32s + (size_t)lrow * 256 + col;
                        else if ((pm & 31) == 31 && ai == 1) dst = o32p + (size_t)((pm >> 5) * 128 + (lrow - 128)) * 256 + col;
                        if (dst) {
#pragma unroll
                            for (int bj = 0; bj < 2; ++bj) { *(f32x4*)(dst + 32 * bj) = v[bj][0]; *(f32x4*)(dst + 32 * bj + 4) = v[bj][1]; }
                        }
                    }
                }
        } else {
            const int col = 256 * (pn - 22) + 32 * wc + 8 * fq;
#pragma unroll
            for (int ai = 0; ai < 2; ++ai)
#pragma unroll
                for (int m = 0; m < 4; ++m) {
                    const size_t row = grow0 + ai * HALF + m * 16;
#pragma unroll
                    for (int bj = 0; bj < 2; ++bj) {
                        f32x4 r0, r1;
#pragma unroll
                        for (int j = 0; j < 1; ++j) { r0 = sigmoid255(acc[ai][bj][m][0]); r1 = sigmoid255(acc[ai][bj][m][1]); }
                        unsigned w0 = 0u, w1 = 0u;
                        w0 = __builtin_amdgcn_cvt_pk_u8_f32(r0[0], 0, w0); w0 = __builtin_amdgcn_cvt_pk_u8_f32(r0[1], 1, w0); w0 = __builtin_amdgcn_cvt_pk_u8_f32(r0[2], 2, w0); w0 = __builtin_amdgcn_cvt_pk_u8_f32(r0[3], 3, w0);
                        w1 = __builtin_amdgcn_cvt_pk_u8_f32(r1[0], 0, w1); w1 = __builtin_amdgcn_cvt_pk_u8_f32(r1[1], 1, w1); w1 = __builtin_amdgcn_cvt_pk_u8_f32(r1[2], 2, w1); w1 = __builtin_amdgcn_cvt_pk_u8_f32(r1[3], 3, w1);
                        typedef unsigned u32x2_t __attribute__((ext_vector_type(2)));
                        *(u32x2_t*)((unsigned char*)SG + row * 1024 + col + 128 * bj) = (u32x2_t){w0, w1};
                    }
                }
        }
    }
};

#ifndef NT_Y
#define NT_Y 0
#endif
#ifndef NT_XN
#define NT_XN 1
#endif
#ifndef NT_X1B
#define NT_X1B 1
#endif
#define NT_IFE(c, p) ((c) ? __builtin_nontemporal_load(p) : *(p))
#if NT_Y
#define NT_STORE(p, v) __builtin_nontemporal_store((v), (p))
#else
#define NT_STORE(p, v) (*(p) = (v))
#endif
struct EpiOut {
    static constexpr bool PERM = true, AFTER_DRAIN = false;
    const bf16_t* XN; const float* IR; const float* nw; bf16_t* X1B; float* SS; PG8_LAS float* ssbuf;
    struct Pre {}; __device__ __forceinline__ void prefetch(const Unit&, Pre&, int, int, int) const {}
    __device__ __forceinline__ void operator()(const f32x4 (&acc)[2][2][4][2], const Unit& u, int wr, int wc, int fr, int fq, const Pre&) const {
        asm volatile("" : "+v"(fr), "+v"(fq), "+s"(wr), "+s"(wc));
        const int pm = u.pm; const int col = 256 * u.pn + 32 * wc + 8 * fq;
        const int lrow0 = wr * 64 + fr;
        f32x4 iw[2][2];
#pragma unroll
        for (int bj = 0; bj < 2; ++bj)
#pragma unroll
            for (int n = 0; n < 2; ++n) { const f32x4 w4 = *(const __attribute__((address_space(1))) f32x4*)(nw + col + 128 * bj + 4 * n);
#pragma unroll
                for (int j = 0; j < 4; ++j) iw[bj][n][j] = __builtin_amdgcn_rcpf(w4[j]); }
#pragma unroll
        for (int ai = 0; ai < 2; ++ai) {
            u32x4 xw[4][2]; float ir[4];
#pragma unroll
            for (int m = 0; m < 4; ++m) { const size_t row = (size_t)pm * BM + lrow0 + ai * HALF + m * 16; ir[m] = IR[row];
#pragma unroll
                for (int bj = 0; bj < 2; ++bj) xw[m][bj] = NT_IFE(NT_XN, (const __attribute__((address_space(1))) u32x4*)(XN + row * 1024 + col + 128 * bj)); }
            asm volatile("" ::: "memory");
#pragma unroll
            for (int m = 0; m < 4; ++m) {
                const int lrow = lrow0 + ai * HALF + m * 16; const size_t row = (size_t)pm * BM + lrow;
                float ss = 0.f;
#pragma unroll
                for (int bj = 0; bj < 2; ++bj) {
                    const u32x4 w = xw[m][bj]; f32x4 x0, x1;
                    x0[0] = __uint_as_float(w.x << 16); x0[1] = __uint_as_float(w.x & 0xffff0000u); x0[2] = __uint_as_float(w.y << 16); x0[3] = __uint_as_float(w.y & 0xffff0000u);
                    x1[0] = __uint_as_float(w.z << 16); x1[1] = __uint_as_float(w.z & 0xffff0000u); x1[2] = __uint_as_float(w.w << 16); x1[3] = __uint_as_float(w.w & 0xffff0000u);
                    const f32x4 y0 = x0 * iw[bj][0] * ir[m] + acc[ai][bj][m][0], y1 = x1 * iw[bj][1] * ir[m] + acc[ai][bj][m][1];
                    ss += (y0[0] * y0[0] + y0[1] * y0[1]) + (y0[2] * y0[2] + y0[3] * y0[3]) + (y1[0] * y1[0] + y1[1] * y1[1]) + (y1[2] * y1[2] + y1[3] * y1[3]);
                    *(u32x4*)(X1B + row * 1024 + col + 128 * bj) = pack8(y0, y1);
                }
                ss += __shfl_xor(ss, 16); ss += __shfl_xor(ss, 32);
                if (fq == 0) ssbuf[lrow * 4 + wc] = ss;
            }
        }
        asm volatile("s_waitcnt lgkmcnt(0)" ::: "memory"); __builtin_amdgcn_s_barrier(); asm volatile("" ::: "memory");
        { const int t = threadIdx.x; if (t < 256) { const float a = ssbuf[t * 4 + 0], b = ssbuf[t * 4 + 1], c = ssbuf[t * 4 + 2], d = ssbuf[t * 4 + 3]; SS[(size_t)u.pn * MROWS + (size_t)pm * BM + t] = (a + b) + (c + d); } }
        asm volatile("s_waitcnt lgkmcnt(0)" ::: "memory"); __builtin_amdgcn_s_barrier(); asm volatile("" ::: "memory");
    }
};

struct EpiGU {
    static constexpr bool PERM = true, AFTER_DRAIN = false;
    const float* SS; bf16_t* H;
    struct Pre { float sv[2][4]; };
    __device__ __forceinline__ void prefetch(const Unit& u, Pre& p, int wr, int fr, int fq) const {
#pragma unroll
        for (int ai = 0; ai < 2; ++ai)
#pragma unroll
            for (int m = 0; m < 4; ++m) p.sv[ai][m] = SS[(size_t)fq * MROWS + (size_t)u.pm * BM + wr * 64 + fr + ai * HALF + m * 16];
    }
    __device__ __forceinline__ void operator()(const f32x4 (&acc)[2][2][4][2], const Unit& u, int wr, int wc, int fr, int fq, const Pre& pre) const {
        asm volatile("" : "+v"(fr), "+v"(fq), "+s"(wr), "+s"(wc));
        const int col = 128 * u.pn + 32 * wc + 8 * fq; const int lrow0 = wr * 64 + fr;
#pragma unroll
        for (int ai = 0; ai < 2; ++ai)
#pragma unroll
            for (int m = 0; m < 4; ++m) {
                const size_t row = (size_t)u.pm * BM + lrow0 + ai * HALF + m * 16;
                float ss = pre.sv[ai][m];
                ss += __shfl_xor(ss, 16); ss += __shfl_xor(ss, 32);
                const float ms = ss * (1.0f / 1024.0f) + RMS_EPS; const float rs = __builtin_amdgcn_rsqf(ms);
                const float c1 = -1.4426950408889634f * rs;
                const f32x4 msv = {ms, ms, ms, ms};
                const f32x4 t0 = acc[ai][0][m][0] * c1, t1 = acc[ai][0][m][1] * c1;
                f32x4 e0, e1;
#pragma unroll
                for (int j = 0; j < 4; ++j) { e0[j] = __builtin_amdgcn_exp2f(t0[j]); e1[j] = __builtin_amdgcn_exp2f(t1[j]); }
                e0 = e0 * ms + msv; e1 = e1 * ms + msv;
                f32x4 s0, s1;
#pragma unroll
                for (int j = 0; j < 4; ++j) { s0[j] = __builtin_amdgcn_rcpf(e0[j]); s1[j] = __builtin_amdgcn_rcpf(e1[j]); }
                const f32x4 r0 = (acc[ai][0][m][0] * acc[ai][1][m][0]) * s0, r1 = (acc[ai][0][m][1] * acc[ai][1][m][1]) * s1;
                *(u32x4*)(H + row * 2816 + col) = pack8(r0, r1);
            }
    }
};

struct EpiDown {
    static constexpr bool PERM = true, AFTER_DRAIN = false;
    float* Y; const bf16_t* X1B;
    struct Pre {}; __device__ __forceinline__ void prefetch(const Unit&, Pre&, int, int, int) const {}
    __device__ __forceinline__ void operator()(const f32x4 (&acc)[2][2][4][2], const Unit& u, int wr, int wc, int fr, int fq, const Pre&) const {
        asm volatile("" : "+v"(fr), "+v"(fq), "+s"(wr), "+s"(wc));
        const int col = 256 * u.pn + 32 * wc + 8 * fq; const int lrow0 = wr * 64 + fr;
        u32x4 xw[2][4][2];
#pragma unroll
        for (int ai = 0; ai < 2; ++ai)
#pragma unroll
            for (int m = 0; m < 4; ++m) { const size_t off = ((size_t)u.pm * BM + lrow0 + ai * HALF + m * 16) * 1024 + col;
#pragma unroll
                for (int bj = 0; bj < 2; ++bj) xw[ai][m][bj] = NT_IFE(NT_X1B, (const __attribute__((address_space(1))) u32x4*)(X1B + off + 128 * bj)); }
        asm volatile("" ::: "memory");
#pragma unroll
        for (int ai = 0; ai < 2; ++ai)
#pragma unroll
            for (int m = 0; m < 4; ++m) {
                const size_t off = ((size_t)u.pm * BM + lrow0 + ai * HALF + m * 16) * 1024 + col;
#pragma unroll
                for (int bj = 0; bj < 2; ++bj) {
                    const u32x4 w = xw[ai][m][bj];
                    f32x4 x0, x1;
                    x0[0] = __uint_as_float(w.x << 16); x0[1] = __uint_as_float(w.x & 0xffff0000u); x0[2] = __uint_as_float(w.y << 16); x0[3] = __uint_as_float(w.y & 0xffff0000u);
                    x1[0] = __uint_as_float(w.z << 16); x1[1] = __uint_as_float(w.z & 0xffff0000u); x1[2] = __uint_as_float(w.w << 16); x1[3] = __uint_as_float(w.w & 0xffff0000u);
                    NT_STORE((f32x4*)(Y + off + 128 * bj), x0 + acc[ai][bj][m][0]); NT_STORE((f32x4*)(Y + off + 128 * bj + 4), x1 + acc[ai][bj][m][1]);
                }
            }
    }
};
template <class Epi, class Sched, bool ALIGN_EPI = false, bool SP2 = false, int AUXA = 0  >
__device__ __forceinline__ void gemm_phase(PG8_LAS unsigned char* lds, const Gemm g, const Sched& S, const Epi& E) {
    int tid_ = threadIdx.x; asm volatile("" : "+v"(tid_));
    const int tid = tid_, wid = __builtin_amdgcn_readfirstlane(tid >> 6), lane = tid & 63, wr = wid >> 2, wc = wid & 3, fr = lane & 15, fq = lane >> 4;
    const int K = g.K, nt = K / BK;
    unsigned voffA[2], voffB[2];
#pragma unroll
    for (int i = 0; i < 2; ++i) { int R, C; stage_rc(tid * 16 + i * 8192, R, C); const int Rb = Epi::PERM ? ((R & ~31) + perm32(R & 31)) : R;
        voffA[i] = (unsigned)(R * K + C) * 2u; voffB[i] = (unsigned)(Rb * K + C) * 2u; }
    const size_t kstep = (size_t)(BK * 2);
    const size_t hstep = (size_t)HALF * K * 2;
    const size_t tstep = 2 * hstep;
    const unsigned ldsw = (unsigned)wid * 1024u;
    const int aoff = lds_byte(wr * 64 + fr, fq * 8), boff = lds_byte(wc * 32 + fr, fq * 8);
#define PG8_SA(b, h) (((b) * 2 + (h)) * HTB)
#define PG8_SB(b, h) ((4 + (b) * 2 + (h)) * HTB)
#define PG8_STAGE_X(bufoff, gbase, voff, AUX_) do { _Pragma("unroll") for (int _i = 0; _i < 2; ++_i) \
        __builtin_amdgcn_global_load_lds((const unsigned*)((const char*)(gbase) + (voff)[_i]), (PG8_LAS unsigned*)(lds + (bufoff) + ldsw + _i * 8192), 16, 0, AUX_); } while (0)
#define PG8_STAGE(bufoff, gbase, voff) do { if constexpr (AUXA == 2) { if (&(voff) == &voffA) PG8_STAGE_X(bufoff, gbase, voff, 2); else PG8_STAGE_X(bufoff, gbase, voff, 0); } else PG8_STAGE_X(bufoff, gbase, voff, 0); } while (0)
#define PG8_LDA(dst, b, h) do { _Pragma("unroll") for (int m = 0; m < 4; ++m) _Pragma("unroll") for (int k = 0; k < 2; ++k) dst[m][k] = *(const PG8_LAS bf16x8*)(lds + PG8_SA(b, h) + aoff + m * 2048 + k * 1024); } while (0)
#define PG8_LDB(dst, b, h) do { _Pragma("unroll") for (int n = 0; n < 2; ++n) _Pragma("unroll") for (int k = 0; k < 2; ++k) dst[n][k] = *(const PG8_LAS bf16x8*)(lds + PG8_SB(b, h) + boff + n * 2048 + k * 1024); } while (0)
#define PG8_MMA(ai, bj, At, Bt) do { __builtin_amdgcn_s_setprio(1); _Pragma("unroll") for (int m = 0; m < 4; ++m) _Pragma("unroll") for (int n = 0; n < 2; ++n) _Pragma("unroll") for (int k = 0; k < 2; ++k) \
        acc[ai][bj][m][n] = __builtin_amdgcn_mfma_f32_16x16x32_bf16(Bt[n][k], At[m][k], acc[ai][bj][m][n], 0, 0, 0); __builtin_amdgcn_s_setprio(0); } while (0)
#define PG8_WAIT_V(n) asm volatile("s_waitcnt vmcnt(" #n ")" ::: "memory")
#define PG8_WAIT_L(n) asm volatile("s_waitcnt lgkmcnt(" #n ")" ::: "memory")
#define PG8_BAR __builtin_amdgcn_s_barrier()
#define PG8_SCHED __builtin_amdgcn_sched_barrier(0)
    Unit cur, nxt; int ui = 0;
    if (!S.next(0, cur)) return;
    typename Epi::Pre pre;
    f32x4 acc[2][2][4][2];
#pragma unroll
    for (int a = 0; a < 2; ++a)
#pragma unroll
        for (int b = 0; b < 2; ++b)
#pragma unroll
            for (int m = 0; m < 4; ++m)
#pragma unroll
                for (int n = 0; n < 2; ++n) acc[a][b][m][n] = (f32x4){0.f, 0.f, 0.f, 0.f};
    bf16x8 At[4][2], B0[2][2], B1[2][2];
    const char* cA = (const char*)g.A + (size_t)(cur.pm & g.amask) * tstep; const char* cB = (const char*)g.Bt + (size_t)(cur.pn & g.bmask) * tstep;
    S.a_ready(cur);
    if constexpr (SP2) {
        PG8_STAGE(PG8_SB(0, 0), cB, voffB); PG8_STAGE(PG8_SB(0, 1), cB + hstep, voffB); PG8_STAGE(PG8_SA(0, 0), cA, voffA); PG8_STAGE(PG8_SA(0, 1), cA + hstep, voffA);
        if (wr == 1) PG8_BAR;
        PG8_WAIT_V(2); PG8_BAR;
        PG8_STAGE(PG8_SB(1, 0), cB + kstep, voffB); PG8_STAGE(PG8_SA(1, 0), cA + kstep, voffA); PG8_STAGE(PG8_SB(1, 1), cB + hstep + kstep, voffB);
        PG8_WAIT_V(6); PG8_BAR;
    } else {
        PG8_STAGE(PG8_SB(0, 0), cB, voffB); PG8_STAGE(PG8_SA(0, 0), cA, voffA); PG8_STAGE(PG8_SB(0, 1), cB + hstep, voffB); PG8_STAGE(PG8_SA(0, 1), cA + hstep, voffA);
        if (wr == 1) PG8_BAR;
        PG8_WAIT_V(4); PG8_BAR;
        PG8_STAGE(PG8_SB(1, 0), cB + kstep, voffB); PG8_STAGE(PG8_SA(1, 0), cA + kstep, voffA); PG8_STAGE(PG8_SB(1, 1), cB + hstep + kstep, voffB);
        PG8_WAIT_V(6); PG8_BAR;
    }
    for (;;) {
        const bool has_next = S.next(ui + 1, nxt);
        const char* nA = has_next ? (const char*)g.A + (size_t)(nxt.pm & g.amask) * tstep : cA; const char* nB = has_next ? (const char*)g.Bt + (size_t)(nxt.pn & g.bmask) * tstep : cB;
        for (int t = 0; t < nt; t += 2) {
            const bool last = (t == nt - 2);
            const char* a1 = cA + (size_t)(t + 1) * kstep;
            const char* a2 = last ? nA : cA + (size_t)(t + 2) * kstep; const char* b2 = last ? nB : cB + (size_t)(t + 2) * kstep;
            const char* a3 = a2 + kstep; const char* b3 = b2 + kstep;
            if (last && has_next) S.a_ready(nxt);
            if (last) E.prefetch(cur, pre, wr, fr, fq);
            if constexpr (SP2) {
            PG8_LDB(B0, 0, 0); PG8_LDB(B1, 0, 1); PG8_SCHED; PG8_LDA(At, 0, 0); PG8_STAGE(PG8_SA(1, 1), a1 + hstep, voffA);
            PG8_WAIT_V(8); PG8_WAIT_L(0); PG8_BAR; PG8_MMA(0, 0, At, B0); PG8_MMA(0, 1, At, B1); PG8_BAR; PG8_SCHED;
            PG8_LDA(At, 0, 1); PG8_STAGE(PG8_SB(0, 0), b2, voffB); PG8_STAGE(PG8_SB(0, 1), b2 + hstep, voffB); PG8_STAGE(PG8_SA(0, 0), a2, voffA);
            PG8_WAIT_V(8); PG8_WAIT_L(0); PG8_BAR; PG8_MMA(1, 0, At, B0); PG8_MMA(1, 1, At, B1); PG8_BAR; PG8_SCHED;
            PG8_LDB(B0, 1, 0); PG8_LDB(B1, 1, 1); PG8_SCHED; PG8_LDA(At, 1, 0); PG8_STAGE(PG8_SA(0, 1), a2 + hstep, voffA);
            PG8_WAIT_V(8); PG8_WAIT_L(0); PG8_BAR; PG8_MMA(0, 0, At, B0); PG8_MMA(0, 1, At, B1); PG8_BAR; PG8_SCHED;
            PG8_LDA(At, 1, 1); PG8_STAGE(PG8_SB(1, 0), b3, voffB); PG8_STAGE(PG8_SB(1, 1), b3 + hstep, voffB); PG8_STAGE(PG8_SA(1, 0), a3, voffA);
            PG8_WAIT_V(8); PG8_WAIT_L(0); PG8_BAR; PG8_MMA(1, 0, At, B0); PG8_MMA(1, 1, At, B1); PG8_BAR; PG8_SCHED;
            } else {
            PG8_LDB(B0, 0, 0); PG8_SCHED; PG8_LDA(At, 0, 0); PG8_STAGE(PG8_SA(1, 1), a1 + hstep, voffA);
            PG8_WAIT_L(8); PG8_BAR; PG8_WAIT_L(0); PG8_MMA(0, 0, At, B0); PG8_BAR; PG8_SCHED;
            PG8_LDB(B1, 0, 1); PG8_STAGE(PG8_SB(0, 0), b2, voffB);
            PG8_BAR; PG8_WAIT_L(0); PG8_MMA(0, 1, At, B1); PG8_BAR;
            PG8_LDA(At, 0, 1); PG8_STAGE(PG8_SA(0, 0), a2, voffA);
            PG8_BAR; PG8_WAIT_L(0); PG8_MMA(1, 0, At, B0); PG8_BAR; PG8_SCHED;
            PG8_STAGE(PG8_SB(0, 1), b2 + hstep, voffB);
            PG8_WAIT_V(6); PG8_BAR; PG8_MMA(1, 1, At, B1); PG8_BAR;
            PG8_LDB(B0, 1, 0); PG8_SCHED; PG8_LDA(At, 1, 0); PG8_STAGE(PG8_SA(0, 1), a2 + hstep, voffA);
            PG8_WAIT_L(8); PG8_BAR; PG8_WAIT_L(0); PG8_MMA(0, 0, At, B0); PG8_BAR; PG8_SCHED;
            PG8_LDB(B1, 1, 1); PG8_STAGE(PG8_SB(1, 0), b3, voffB);
            PG8_BAR; PG8_WAIT_L(0); PG8_MMA(0, 1, At, B1); PG8_BAR;
            PG8_LDA(At, 1, 1); PG8_STAGE(PG8_SA(1, 0), a3, voffA);
            PG8_BAR; PG8_WAIT_L(0); PG8_MMA(1, 0, At, B0); PG8_BAR; PG8_SCHED;
            PG8_STAGE(PG8_SB(1, 1), b3 + hstep, voffB);
            PG8_WAIT_V(6); PG8_BAR; PG8_MMA(1, 1, At, B1); PG8_BAR;
            }
        }
        if constexpr (ALIGN_EPI) { if (wr == 0) PG8_BAR; }
        if constexpr (!Epi::AFTER_DRAIN) { E(acc, cur, wr, wc, fr, fq, pre); S.done(cur); }
        if (!has_next) break;
#pragma unroll
        for (int a = 0; a < 2; ++a)
#pragma unroll
            for (int b = 0; b < 2; ++b)
#pragma unroll
                for (int m = 0; m < 4; ++m)
#pragma unroll
                    for (int n = 0; n < 2; ++n) acc[a][b][m][n] = (f32x4){0.f, 0.f, 0.f, 0.f};
        cur = nxt; cA = nA; cB = nB; ++ui;
        if constexpr (ALIGN_EPI) { if (wr == 1) PG8_BAR; }
    }
    PG8_WAIT_V(0);
    if constexpr (!ALIGN_EPI) { if (wr == 0) PG8_BAR; }
    PG8_BAR;
    if constexpr (Epi::AFTER_DRAIN) { E.fused(acc, cur, wr, wc, fr, fq, lds, wid, lane); S.done(cur); }
#undef PG8_SA
#undef PG8_SB
#undef PG8_STAGE
#undef PG8_STAGE_X
#undef PG8_LDA
#undef PG8_LDB
#undef PG8_MMA
#undef PG8_WAIT_V
#undef PG8_WAIT_L
#undef PG8_BAR
#undef PG8_SCHED
}
}
#define GAS __attribute__((address_space(1)))
#define LAS __attribute__((address_space(3)))
typedef unsigned short bf16;
typedef unsigned v4u __attribute__((ext_vector_type(4)));
typedef float f32x4 __attribute__((ext_vector_type(4)));
typedef short bf16x8 __attribute__((ext_vector_type(8)));
typedef GAS unsigned gu32;
typedef GAS unsigned long long gu64;
#define RLX_AGENT __ATOMIC_RELAXED, __HIP_MEMORY_SCOPE_AGENT
#define LDS_WAIT() asm volatile("s_waitcnt lgkmcnt(0)" ::: "memory")
#define VM_WAIT() asm volatile("s_waitcnt vmcnt(0)" ::: "memory")
__device__ __forceinline__ unsigned long long rt() { return __builtin_amdgcn_s_memrealtime(); }
__device__ __forceinline__ unsigned f2bf(float f) { unsigned u = __builtin_bit_cast(unsigned, f); return (u + 0x7fffu + ((u >> 16) & 1u)) >> 16; }
__device__ __forceinline__ unsigned pk2(float lo, float hi) { return f2bf(lo) | (f2bf(hi) << 16); }

#define XB_TMO      128
#define XB_XCNT(j)  (256  + 64 * (j))
#define XB_XSUB(j)  (1280 + 64 * (j))
#define XB_XGEN(j)  (2304 + 64 * (j))
#define XB_TOP      3328
#define XB_TOPGEN   3392
#define XCD_BAR_WORDS 3456
#define XB_SPIN_CAP (1u << 18)
#ifndef XB_FLAT_RELEASE
#define XB_FLAT_RELEASE 1
#endif
#ifndef XB_EARLY_WB
#define XB_EARLY_WB 1
#endif

__device__ __forceinline__ unsigned xb_ld(unsigned* p)              { return __hip_atomic_load(p, __ATOMIC_RELAXED, __HIP_MEMORY_SCOPE_AGENT); }
__device__ __forceinline__ unsigned xb_add(unsigned* p, unsigned v) { return __hip_atomic_fetch_add(p, v, __ATOMIC_RELAXED, __HIP_MEMORY_SCOPE_AGENT); }
__device__ __forceinline__ unsigned xb_xcc_id() { return (unsigned)__builtin_amdgcn_s_getreg((3 << 11) | 20) & 0xFu; }
#define XB_SPIN(cond, bar) do { unsigned _sp = 0; while (cond) { __builtin_amdgcn_s_sleep(1); \
    if ((++_sp & 255u) == 0u) { if (xb_ld(&(bar)[XB_TMO])) break; if (_sp > XB_SPIN_CAP) { atomicAdd(&(bar)[XB_TMO], 1u); break; } } } } while (0)

struct XcdBarrier {
    unsigned* bar; unsigned x;
    volatile LAS unsigned* st;
};

__device__ __forceinline__ XcdBarrier xcd_barrier_post(unsigned* bar, volatile LAS unsigned* st) {
    XcdBarrier b; b.bar = bar; b.x = xb_xcc_id(); b.st = st;
    if (threadIdx.x == 0) (void)xb_add(&bar[XB_XCNT(b.x)], 1u);
    return b;
}
__device__ __forceinline__ void xcd_barrier_complete(unsigned* bar, unsigned x, unsigned& nloc, unsigned& nx) {
    const unsigned G = gridDim.x * gridDim.y * gridDim.z;
    unsigned sum, cnt, mine, sp = 0u;
    for (;;) {
        sum = 0u; cnt = 0u; mine = 0u;
#pragma unroll
        for (unsigned j = 0; j < 16; ++j) { const unsigned c = xb_ld(&bar[XB_XCNT(j)]); sum += c; cnt += (c > 0u) ? 1u : 0u; mine = (j == x) ? c : mine; }
        if (sum == G) break;
        __builtin_amdgcn_s_sleep(1);
        if ((++sp & 255u) == 0u) { if (xb_ld(&bar[XB_TMO])) break; if (sp > XB_SPIN_CAP) { atomicAdd(&bar[XB_TMO], 1u); break; } }
    }
    nloc = mine > 0u ? mine : 1u; nx = cnt > 0u ? cnt : 1u;
}

__device__ __forceinline__ void xcd_barrier(const XcdBarrier& b) {
    asm volatile("s_waitcnt vmcnt(0)" ::: "memory");
    __syncthreads();
    if (threadIdx.x == 0) {
        unsigned* bar = b.bar;
        __builtin_amdgcn_s_waitcnt(0);
        unsigned nloc = b.st[0], nx = b.st[1];
        if (nloc == 0u) { xcd_barrier_complete(bar, b.x, nloc, nx); b.st[0] = nloc; b.st[1] = nx; }
        const unsigned old = xb_add(&bar[XB_XSUB(b.x)], 1u);
        const unsigned gen = old / nloc;
#if XB_EARLY_WB
        if (old == gen * nloc && nloc > 1u) {
            __builtin_amdgcn_fence(__ATOMIC_RELEASE, "agent");
            asm volatile("s_waitcnt vmcnt(0)" ::: "memory"); }
#endif
        if (old + 1u == (gen + 1u) * nloc) {
            __builtin_amdgcn_fence(__ATOMIC_RELEASE, "agent");
            asm volatile("s_waitcnt vmcnt(0)" ::: "memory");
            const unsigned og = xb_add(&bar[XB_TOP], 1u);
            const unsigned tg = og / nx;
            if (og + 1u == (tg + 1u) * nx) xb_add(&bar[XB_TOPGEN], 1u);
            else XB_SPIN(xb_ld(&bar[XB_TOPGEN]) == tg, bar);
            __builtin_amdgcn_fence(__ATOMIC_ACQUIRE, "agent");
#if !XB_FLAT_RELEASE
            xb_add(&bar[XB_XGEN(b.x)], 1u);
#endif
            asm volatile("s_waitcnt vmcnt(0)" ::: "memory");
        } else {
#if XB_FLAT_RELEASE
            XB_SPIN(xb_ld(&bar[XB_TOPGEN]) == gen, bar);
#else
            XB_SPIN(xb_ld(&bar[XB_XGEN(b.x)]) == gen, bar);
#endif
            __builtin_amdgcn_fence(__ATOMIC_ACQUIRE, "agent");
            asm volatile("s_waitcnt vmcnt(0)" ::: "memory");
        }
    }
    __syncthreads();
}
constexpr int NWAVES = 8;
constexpr int D = 1024, MROWS = pg8::MROWS, MP = pg8::MP, SEQ_T = 8192, NB = 4, NCH = 128, DFF = 2816, NIN = 6656, NGU = 5632;
constexpr int DEC_B = 16, DEC_T = 16, CACHE_L = 128;
constexpr size_t MiB = 1u << 20;
constexpr size_t WS_BASE = 40 * MiB;
constexpr size_t WS_CTL = 0, CTL_ZERO_BYTES = 64 * 1024;
constexpr size_t WS_SS = 2 * MiB, WS_CK = 5 * MiB, WS_CV = 6 * MiB;
constexpr size_t WS_WIN = 8 * MiB, WS_WOUT = 21 * MiB, WS_WGU = 23 * MiB, WS_WD = 34 * MiB;
constexpr size_t WS_XN = 40 * MiB;
constexpr size_t WS_Q = 105 * MiB;
constexpr size_t WS_K = 170 * MiB, WS_V = 187 * MiB;
constexpr size_t WS_U = 204 * MiB, WS_BG = 269 * MiB, WS_SG = 334 * MiB;
constexpr size_t WS_H = 170 * MiB;
constexpr size_t WS_HS = 399 * MiB;
constexpr size_t WS_MGS = 401 * MiB;
constexpr size_t WS_MG = 402 * MiB;
constexpr size_t WS_IR = 467 * MiB;
constexpr size_t WS_END = 468 * MiB;
static_assert(WS_SS + (size_t)MROWS * 16 * 4 <= WS_CK && WS_WIN + (size_t)NIN * D * 2 <= WS_WOUT && WS_WGU + (size_t)NGU * D * 2 <= WS_WD && WS_WD + (size_t)D * DFF * 2 <= WS_XN, "ws map 1");
static_assert(WS_XN + (size_t)MROWS * D * 2 <= WS_Q && WS_Q + (size_t)MROWS * D * 2 <= WS_K && WS_K + (size_t)(MROWS + 64) * 256 * 2 <= WS_V && WS_V + (size_t)(MROWS + 64) * 256 * 2 <= WS_U, "ws map 2");
static_assert(WS_U + (size_t)MROWS * D * 2 <= WS_BG && WS_BG + (size_t)MROWS * D * 2 <= WS_SG && WS_SG + (size_t)MROWS * D * 2 <= WS_HS && WS_H + (size_t)MROWS * DFF * 2 <= WS_HS && WS_HS + (size_t)256 * DFF * 2 <= WS_MGS && WS_MGS + (size_t)256 * D * 2 <= WS_MG && WS_MG + (size_t)MROWS * D * 2 <= WS_IR && WS_IR + (size_t)MROWS * 4 <= WS_END, "ws map 3");
static_assert(WS_Q == pg8::EO_Q && WS_K == pg8::EO_K && WS_V == pg8::EO_V && WS_U == pg8::EO_U && WS_BG == pg8::EO_BG && WS_SG == pg8::EO_SG, "epilogue offsets");
constexpr int CW_TMO = 0, CW_CODE = 1, CW_BAR = 4096;
static_assert((CW_BAR + 3456) * 4 <= (int)CTL_ZERO_BYTES, "control words inside the per-call memset");

constexpr int RING_OFF = 0, RING_BYTES = 131072;
constexpr int LDSCTL_OFF = 139264, MISC_OFF = LDSCTL_OFF + 320;
constexpr int LDS_BYTES = 147456;

struct Frame {
    LAS unsigned char* lds;
    volatile LAS unsigned* MISC;
    gu32* ctl;
    int tid, lane, wave;
    int vcu, G;
    const float *xp, *xs, *state_conv, *cache_k, *cache_v, *norm_mix_w, *w_in, *conv_w, *q_norm_w, *k_norm_w, *sinks, *w_out, *norm_ffn_w, *w_gate, *w_up, *w_down;
    float* out;
    bf16 *Win_t, *Wout_t, *Wgu_t, *Wd_t;
    bf16 *XN, *MG, *Q, *X1B, *KB, *VB, *U, *BG, *SG, *H, *CK, *CV;
    float* SS; float* IR;
};

#ifndef NT_P0
#define NT_P0 1
#endif
#ifndef NT_MRG
#define NT_MRG 1
#endif
#ifndef NT_Q
#define NT_Q 0
#endif
#define NT_IF(c, p) ((c) ? __builtin_nontemporal_load(p) : *(p))
#if NT_P0
#define NT_LOAD(p) __builtin_nontemporal_load(p)
#else
#define NT_LOAD(p) (*(p))
#endif
__device__ __forceinline__ float wave_sum(float v) {
#pragma unroll
    for (int o = 1; o < 64; o <<= 1) v += __shfl_xor(v, o);
    return v;
}
struct WItem { const float* W; bf16* WT; const float* sc; int K, N, k0, n0, drow0; };
__device__ __forceinline__ void p0_item_load(const WItem& w, f32x4 (&t)[8], int lane) {
#pragma unroll
    for (int i = 0; i < 8; ++i) t[i] = NT_LOAD((const GAS f32x4*)(w.W + (size_t)(w.k0 + 8 * i + (lane >> 3)) * w.N + w.n0 + 4 * (lane & 7)));
}
__device__ __forceinline__ void p0_item_finish(const WItem& w, const f32x4 (&t)[8], LAS float* scr, int lane) {
#pragma unroll
    for (int i = 0; i < 8; ++i) { const int kk = 8 * i + (lane >> 3); f32x4 v = t[i]; if (w.sc) v = v * w.sc[w.k0 + kk]; LAS float* d = scr + kk * 33 + 4 * (lane & 7); d[0] = v.x; d[1] = v.y; d[2] = v.z; d[3] = v.w; }
    LDS_WAIT(); asm volatile("" ::: "memory");
    const int c = lane & 7;
#pragma unroll
    for (int j = 0; j < 4; ++j) { const int n = (lane >> 3) + 8 * j; const LAS float* s = scr + (8 * c) * 33 + n;
        v4u o; o.x = pk2(s[0 * 33], s[1 * 33]); o.y = pk2(s[2 * 33], s[3 * 33]); o.z = pk2(s[4 * 33], s[5 * 33]); o.w = pk2(s[6 * 33], s[7 * 33]);
        *(GAS v4u*)(w.WT + (size_t)(w.drow0 + n) * w.K + w.k0 + 8 * c) = o; }
    LDS_WAIT(); asm volatile("" ::: "memory");
}
__device__ __forceinline__ int win_dest_row(int n) {
    if (n < 1024) return 256 * (n >> 7) + (n & 127);
    if (n < 2048) { const int q = n - 1024; return 256 * (8 + (q >> 7)) + (q & 127); }
    if (n < 3072) { const int q = n - 2048; return 256 * (q >> 7) + 128 + (q & 127); }
    if (n < 4608) { const int q = n - 3072; const int t = q >> 8, r = q & 255;
                    return 256 * (16 + t) + 128 * ((r >> 5) & 1) + 32 * (r >> 6) + (r & 31); }
    if (n < 5632) { const int q = n - 4608; return 256 * (8 + (q >> 7)) + 128 + (q & 127); }
    return 256 * 22 + (n - 5632);
}
__device__ __forceinline__ void rms_row_to_bf16(Frame& F, const float* xrow, const float* w, bf16* orow) {
    const GAS f32x4* xr = (const GAS f32x4*)xrow + F.lane; const GAS f32x4* wr = (const GAS f32x4*)w + F.lane;
    f32x4 v[4]; float s2 = 0.f;
#pragma unroll
    for (int j = 0; j < 4; ++j) { v[j] = xr[64 * j]; s2 += (v[j].x * v[j].x + v[j].y * v[j].y) + (v[j].z * v[j].z + v[j].w * v[j].w); }
    const float rstd = __builtin_amdgcn_rsqf(wave_sum(s2) * (1.f / D) + pg8::RMS_EPS);
    GAS unsigned long long* o8 = (GAS unsigned long long*)orow + F.lane;
#pragma unroll
    for (int j = 0; j < 4; ++j) { const f32x4 ww = wr[64 * j]; o8[64 * j] = (unsigned long long)pk2(v[j].x * rstd * ww.x, v[j].y * rstd * ww.y) | ((unsigned long long)pk2(v[j].z * rstd * ww.z, v[j].w * rstd * ww.w) << 32); }
}
constexpr int I_IN = (D / 64) * (NIN / 32), I_O = (D / 64) * (D / 32), I_G = (D / 64) * (DFF / 32), I_D = (DFF / 64) * (D / 32);
__device__ __forceinline__ void p0_item_decode(Frame& F, int it, WItem& w) {
    int r = it; w.sc = nullptr;
    if (r < I_IN) { const int nblk = NIN / 32, kb = r / nblk, nb = r % nblk; w.W = F.w_in; w.K = D; w.N = NIN; w.WT = F.Win_t; w.k0 = 64 * kb; w.n0 = 32 * nb; w.drow0 = win_dest_row(32 * nb); return; } r -= I_IN;
    if (r < I_O) { const int nblk = D / 32, kb = r / nblk, nb = r % nblk; w.W = F.w_out; w.K = D; w.N = D; w.WT = F.Wout_t; w.k0 = 64 * kb; w.n0 = 32 * nb; w.drow0 = 32 * nb; return; } r -= I_O;
    if (r < 2 * I_G) { const int up = r >= I_G; if (up) r -= I_G; const int nblk = DFF / 32, kb = r / nblk, nb = r % nblk, n0 = 32 * nb;
        w.W = up ? F.w_up : F.w_gate; w.K = D; w.N = DFF; w.WT = F.Wgu_t; w.k0 = 64 * kb; w.n0 = n0; w.drow0 = 256 * (n0 >> 7) + 128 * up + (n0 & 127); w.sc = F.norm_ffn_w; return; } r -= 2 * I_G;
    { const int nblk = D / 32, kb = r / nblk, nb = r % nblk; w.W = F.w_down; w.K = DFF; w.N = D; w.WT = F.Wd_t; w.k0 = 64 * kb; w.n0 = 32 * nb; w.drow0 = 32 * nb; }
}
__device__ __forceinline__ void p0_weight_range(Frame& F, int first, int count, int start, int step) {
    LAS float* scr = (LAS float*)(F.lds + RING_OFF + F.wave * 16384);
    int it = start; if (it >= count) return;
    WItem A, B; f32x4 ta[8], tb[8];
    p0_item_decode(F, first + it, A); p0_item_load(A, ta, F.lane);
    for (;;) {
        const int itn = it + step; const bool hn = itn < count;
        if (hn) { p0_item_decode(F, first + itn, B); p0_item_load(B, tb, F.lane); }
        p0_item_finish(A, ta, scr, F.lane);
        if (!hn) break;
        it = itn + step; const bool hn2 = it < count;
        if (hn2) { p0_item_decode(F, first + it, A); p0_item_load(A, ta, F.lane); }
        p0_item_finish(B, tb, scr, F.lane);
        if (!hn2) break;
    }
}
__device__ __forceinline__ void p0_weight_items(Frame& F, int first, int count, int w, int nw) { p0_weight_range(F, first, count, w * NWAVES + F.wave, nw * NWAVES); }
__device__ __forceinline__ void p0_prologue(Frame& F, bool defer_w) {
    LAS float* scr = (LAS float*)(F.lds + RING_OFF + F.wave * 16384);
    const int gw = F.vcu * NWAVES + F.wave, NGW = F.G * NWAVES;
    const int NITEMS = defer_w ? I_IN : I_IN + I_O + 2 * I_G + I_D;
    f32x4 nw[4];
#pragma unroll
    for (int j = 0; j < 4; ++j) nw[j] = ((const GAS f32x4*)F.norm_mix_w)[F.lane + 64 * j];
#define P0_LOADG(V, M0) do { _Pragma("unroll") for (int r = 0; r < 4; ++r) { const int m = (M0) + r * NGW; if (m < MROWS) { \
        const GAS f32x4* xr = (const GAS f32x4*)(m < MP ? F.xp + (size_t)m * D : F.xs + (size_t)(m - MP) * D) + F.lane; \
        _Pragma("unroll") for (int j = 0; j < 4; ++j) V[r][j] = NT_LOAD(xr + 64 * j); } } } while (0)
#define P0_DOG(V, M0) do { _Pragma("unroll") for (int r = 0; r < 4; ++r) { const int m = (M0) + r * NGW; if (m < MROWS) { \
        float s2 = 0.f; \
        _Pragma("unroll") for (int j = 0; j < 4; ++j) s2 += (V[r][j].x * V[r][j].x + V[r][j].y * V[r][j].y) + (V[r][j].z * V[r][j].z + V[r][j].w * V[r][j].w); \
        const float ms = wave_sum(s2) * (1.f / D) + pg8::RMS_EPS; const float rstd = __builtin_amdgcn_rsqf(ms); \
        if (F.lane == 0) F.IR[m] = __builtin_sqrtf(ms); \
        GAS unsigned long long* o8 = (GAS unsigned long long*)(F.XN + (size_t)m * D) + F.lane; \
        _Pragma("unroll") for (int j = 0; j < 4; ++j) o8[64 * j] = (unsigned long long)pk2(V[r][j].x * rstd * nw[j].x, V[r][j].y * rstd * nw[j].y) | ((unsigned long long)pk2(V[r][j].z * rstd * nw[j].z, V[r][j].w * rstd * nw[j].w) << 32); } } } while (0)
    f32x4 va[4][4], vb[4][4];
    P0_LOADG(va, gw);
    p0_weight_range(F, 0, NITEMS, gw, NGW);
    for (int m0 = gw; m0 < MROWS; m0 += 8 * NGW) {
        P0_LOADG(vb, m0 + 4 * NGW); P0_DOG(va, m0);
        P0_LOADG(va, m0 + 8 * NGW); P0_DOG(vb, m0 + 4 * NGW);
    }
#undef P0_LOADG
#undef P0_DOG
    { const int gt = gw * 64 + F.lane, NT = NGW * 64;
      for (int i = gt; i < DEC_B * CACHE_L * 256 / 4; i += NT) {
          const f32x4 a = ((const GAS f32x4*)F.cache_k)[i], b = ((const GAS f32x4*)F.cache_v)[i];
          ((GAS unsigned long long*)F.CK)[i] = (unsigned long long)pk2(a.x, a.y) | ((unsigned long long)pk2(a.z, a.w) << 32);
          ((GAS unsigned long long*)F.CV)[i] = (unsigned long long)pk2(b.x, b.y) | ((unsigned long long)pk2(b.z, b.w) << 32); }
      for (int i = gt; i < 64 * 256 / 4; i += NT) { ((GAS unsigned long long*)(F.KB + (size_t)MROWS * 256))[i] = 0ull; ((GAS unsigned long long*)(F.VB + (size_t)MROWS * 256))[i] = 0ull; } }
}

namespace p2 {
using bf16x8 = __attribute__((ext_vector_type(8))) short;
using s16x4 = __attribute__((ext_vector_type(4))) short;
using f32x16 = __attribute__((ext_vector_type(16))) float;
typedef short v4i16_t __attribute__((ext_vector_type(4)));
typedef LAS const char* lds_cptr;
constexpr int LDS_K = 0, LDS_V = 3 * 8192, LDS_WS = 6 * 8192, LDS_OST = LDS_WS + 8 * 256, LDS_TOTAL = LDS_OST + 8 * 4096;
__device__ __forceinline__ int crow(int r, int hi) { return (r & 3) + 8 * (r >> 2) + 4 * hi; }
__device__ __forceinline__ s16x4 vtr(lds_cptr p) { return __builtin_bit_cast(s16x4, __builtin_amdgcn_ds_read_tr16_b64_v4i16((LAS v4i16_t*)p)); }
__device__ __forceinline__ unsigned cvtpk(float lo, float hi) { return pg8::cvt_pk_bf16(lo, hi); }
__device__ __forceinline__ float bf_lo(unsigned w) { return __uint_as_float(w << 16); }
__device__ __forceinline__ float bf_hi(unsigned w) { return __uint_as_float(w & 0xffff0000u); }

struct UnitDesc { const bf16* kt[3]; const bf16* vt[3]; int nv[3]; int row0; int g; int sample; int t0; };
constexpr int SET_BYTES = 6 * 8192;
constexpr int OST_ROWB = 144, OST_WAVEB = 32 * OST_ROWB;
constexpr int LDS_WS2 = 2 * SET_BYTES, LDS_OST2 = LDS_WS2 + 8 * 256, LDS_TOTAL2 = LDS_OST2 + 8 * OST_WAVEB;
static_assert(LDS_TOTAL2 + 16 <= LDSCTL_OFF - RING_OFF, "attention phase LDS");

__device__ __forceinline__ void make_prompt_unit(Frame& F, int id, UnitDesc& ud) {
    const int bg = id >> 7, c = id & 127, b = bg >> 2, g = bg & 3;
    ud.g = g; ud.sample = 0; ud.row0 = b * SEQ_T + 64 * c; ud.t0 = 64 * c;
#pragma unroll
    for (int j = 0; j < 3; ++j) { const int cc = c - 2 + j; const int cl = cc < 0 ? 0 : cc; ud.nv[j] = cc < 0 ? 0 : 64;
        const size_t off = (size_t)(b * SEQ_T + 64 * cl) * 256 + 64 * g; ud.kt[j] = F.KB + off; ud.vt[j] = F.VB + off; }
}
__device__ __forceinline__ void make_sample_unit(Frame& F, int id, UnitDesc& ud) {
    const int bs = id >> 2, g = id & 3;
    ud.g = g; ud.sample = 1; ud.row0 = MP + DEC_T * bs; ud.t0 = 0;
    ud.nv[0] = 64; ud.nv[1] = 64; ud.nv[2] = DEC_T;
    const size_t o0 = (size_t)(bs * CACHE_L) * 256 + 64 * g, o2 = (size_t)(MP + DEC_T * bs) * 256 + 64 * g;
    ud.kt[0] = F.CK + o0; ud.vt[0] = F.CV + o0; ud.kt[1] = F.CK + o0 + 64 * 256; ud.vt[1] = F.CV + o0 + 64 * 256; ud.kt[2] = F.KB + o2; ud.vt[2] = F.VB + o2;
}
struct UnitList { int p0, np, s0, ns, sstride, p1 = -1; };
__device__ __forceinline__ void make_unit(Frame& F, const UnitList& L, int i, UnitDesc& ud) { if (i < L.np) make_prompt_unit(F, L.p1 < 0 ? L.p0 + i : (i < 4 ? L.p1 + i : L.p0 + i - 4), ud); else make_sample_unit(F, L.s0 + (i - L.np) * L.sstride, ud); }

__device__ __forceinline__ void issue_kv(Frame& F, const UnitDesc& ud, int setoff) {
    const int lane = F.lane, wid = F.wave;
#pragma unroll
    for (int j = 0; j < 3; ++j) {
        __builtin_amdgcn_global_load_lds((const unsigned*)(ud.kt[j] + (size_t)lane * 256 + wid * 8), (LAS unsigned*)(F.lds + RING_OFF + setoff + j * 8192 + wid * 1024), 16, 0, 0);
        __builtin_amdgcn_global_load_lds((const unsigned*)(ud.vt[j] + (size_t)(16 * (wid & 3) + (lane >> 2)) * 256 + 32 * (wid >> 2) + 8 * (lane & 3)), (LAS unsigned*)(F.lds + RING_OFF + setoff + 3 * 8192 + j * 8192 + wid * 1024), 16, 0, 0);
    }
}
__device__ __forceinline__ const bf16* q_addr(Frame& F, const UnitDesc& ud) {
    const int lane = F.lane, r32 = lane & 31, hi = lane >> 5, hh = F.wave >> 1, half = F.wave & 1;
    int qtok = half * 32 + r32; if (ud.sample && qtok > 15) qtok = 15;
    return F.Q + (size_t)(ud.row0 + qtok) * D + 256 * ud.g + 64 * hh + 8 * hi;
}
__device__ __forceinline__ void load_q(const bf16* qp, bf16x8 (&qr)[4]) {
#pragma unroll
    for (int d0 = 0; d0 < 4; ++d0) qr[d0] = NT_IF(NT_Q, (const GAS bf16x8*)(qp + 16 * d0));
}
typedef unsigned v2u __attribute__((ext_vector_type(2)));
__device__ __forceinline__ void unpack8b(const v2u& w, float (&o)[8]) { o[0] = (float)(w.x & 0xffu); o[1] = (float)((w.x >> 8) & 0xffu); o[2] = (float)((w.x >> 16) & 0xffu); o[3] = (float)(w.x >> 24);
    o[4] = (float)(w.y & 0xffu); o[5] = (float)((w.y >> 8) & 0xffu); o[6] = (float)((w.y >> 16) & 0xffu); o[7] = (float)(w.y >> 24); }
__device__ __forceinline__ void unpack8(const v4u& w, float (&o)[8]) { o[0] = bf_lo(w.x); o[1] = bf_hi(w.x); o[2] = bf_lo(w.y); o[3] = bf_hi(w.y); o[4] = bf_lo(w.z); o[5] = bf_hi(w.z); o[6] = bf_lo(w.w); o[7] = bf_hi(w.w); }

template <int MODE = 0  >
__device__ __forceinline__ void compute_unit(Frame& F, const UnitDesc& ud, int setoff, const bf16x8 (&qr)[4], bf16* mgbase, const bf16* qnp, bf16x8 (&qn)[4]) {
    int lane_ = F.lane; asm volatile("" : "+v"(lane_));
    const int lane = lane_, r32 = lane & 31, hi = lane >> 5, wid = F.wave, hh = wid >> 1, half = wid & 1;
    LAS unsigned char* lds = F.lds + RING_OFF;
    if (ud.sample && half) return;
    f32x16 o[2]; o[0] = f32x16{}; o[1] = f32x16{};
    f32x16 p[6];
    const lds_cptr kp0 = (lds_cptr)(lds + setoff) + hi * 1024 + r32 * 16;
#pragma unroll
    for (int blk = 0; blk < 6; ++blk) {
        f32x16 a = {};
#pragma unroll
        for (int d0 = 0; d0 < 4; ++d0) {
            const bf16x8 kf = *(const LAS bf16x8*)(kp0 + (blk >> 1) * 8192 + (blk & 1) * 512 + d0 * 2048);
            a = __builtin_amdgcn_mfma_f32_32x32x16_bf16(kf, qr[d0], a, 0, 0, 0);
        }
        p[blk] = a;
    }
    const float sink2 = F.sinks[4 * ud.g + hh] * 1.4426950408889634f;
    float l = 0.f, sk = sink2;
    const bool allvalid = ud.nv[0] == 64 && ud.nv[1] == 64 && ud.nv[2] == 64;
    if (!(allvalid && !ud.sample && __builtin_amdgcn_readfirstlane(*(const LAS int*)(lds + LDS_TOTAL2)) != 0)) {
        float mx = sink2;
        if (allvalid) {
#pragma unroll
            for (int blk = 0; blk < 6; ++blk)
#pragma unroll
                for (int r = 0; r < 16; ++r) mx = fmaxf(mx, p[blk][r]);
        } else {
#pragma unroll
            for (int blk = 0; blk < 6; ++blk) {
                const int nvj = ud.nv[blk >> 1];
#pragma unroll
                for (int r = 0; r < 16; ++r) { const int kk = (blk & 1) * 32 + crow(r, hi); const float s = kk < nvj ? p[blk][r] : -1e30f; p[blk][r] = s; mx = fmaxf(mx, s); }
            }
        }
        { auto rr = __builtin_amdgcn_permlane32_swap(__float_as_uint(mx), __float_as_uint(mx), false, false); mx = fmaxf(__uint_as_float(rr[0]), __uint_as_float(rr[1])); }
#pragma unroll
        for (int blk = 0; blk < 6; ++blk)
#pragma unroll
            for (int r = 0; r < 16; ++r) p[blk][r] -= mx;
        sk -= mx;
    }
    const int ch = lane & 7, rb = lane >> 3; const int colg = 256 * ud.g + 64 * hh + 8 * ch;
    int tok0 = half * 32 + 4 * rb;
    const bool lane_on = !ud.sample || rb < 4;
    if (!lane_on) tok0 = 12;
    const size_t rowb = (size_t)ud.row0 + tok0; const int tb = ud.t0 + tok0;
    v2u sgv[4]; v4u bgv[4], uv[6];
    v4u pw[12];
    { typedef float f32x2_t __attribute__((ext_vector_type(2))); f32x2_t l2 = {0.f, 0.f};
#pragma unroll
      for (int blk = 0; blk < 6; ++blk) {
          float e[16];
#pragma unroll
          for (int r = 0; r < 16; r += 2) { e[r] = __builtin_amdgcn_exp2f(p[blk][r]); e[r + 1] = __builtin_amdgcn_exp2f(p[blk][r + 1]); l2 += (f32x2_t){e[r], e[r + 1]}; }
#pragma unroll
          for (int h2 = 0; h2 < 2; ++h2) { v4u w; w.x = cvtpk(e[8 * h2 + 0], e[8 * h2 + 1]); w.y = cvtpk(e[8 * h2 + 2], e[8 * h2 + 3]); w.z = cvtpk(e[8 * h2 + 4], e[8 * h2 + 5]); w.w = cvtpk(e[8 * h2 + 6], e[8 * h2 + 7]); pw[2 * blk + h2] = w; }
          if (blk == 2) {
#pragma unroll
              for (int k = 0; k < 4; ++k) { sgv[k] = NT_IF(NT_MRG, (const GAS v2u*)((const unsigned char*)F.SG + (rowb + k) * D + colg)); bgv[k] = NT_IF(NT_MRG, (const GAS v4u*)(F.BG + (rowb + k) * D + colg)); }
              __builtin_amdgcn_sched_barrier(0);
          }
      }
      l = l2.x + l2.y; }
    { auto rr = __builtin_amdgcn_permlane32_swap(__float_as_uint(l), __float_as_uint(l), false, false); l = __uint_as_float(rr[0]) + __uint_as_float(rr[1]); }
    l += __builtin_amdgcn_exp2f(sk);
#pragma unroll
    for (int j = 0; j < 6; ++j) { const int dj = (tb + j - 2 >= 0) ? j - 2 : 0; uv[j] = NT_IF(NT_MRG, (const GAS v4u*)(F.U + (size_t)((long)rowb + dj) * D + colg)); }
    const lds_cptr vp0 = (lds_cptr)(lds + setoff + 3 * 8192) + ((lane >> 4) & 1) * 32 + (lane & 3) * 8 + (4 * hi + ((lane & 15) >> 2)) * 64;
#pragma unroll
    for (int ks = 0; ks < 12; ++ks) {
        const bf16x8 pa = __builtin_bit_cast(bf16x8, pw[ks]);
#pragma unroll
        for (int d0 = 0; d0 < 2; ++d0) {
            const lds_cptr vp = vp0 + (ks >> 2) * 8192 + d0 * 4096 + (ks & 3) * 1024;
            const s16x4 lo = vtr(vp), hi4 = vtr(vp + 512);
            const bf16x8 vf = (bf16x8){lo[0], lo[1], lo[2], lo[3], hi4[0], hi4[1], hi4[2], hi4[3]};
            o[d0] = __builtin_amdgcn_mfma_f32_32x32x16_bf16(vf, pa, o[d0], 0, 0, 0);
        }
    }
    if (qnp) load_q(qnp, qn);
    LAS unsigned char* stg = (LAS unsigned char*)(lds + LDS_OST2) + wid * OST_WAVEB;
    { const float rl = __builtin_amdgcn_rcpf(l * 255.f);
#pragma unroll
      for (int d0 = 0; d0 < 2; ++d0)
#pragma unroll
          for (int g = 0; g < 4; ++g) {
              v2u w; w.x = cvtpk(o[d0][4 * g + 0] * rl, o[d0][4 * g + 1] * rl); w.y = cvtpk(o[d0][4 * g + 2] * rl, o[d0][4 * g + 3] * rl);
              *(LAS v2u*)(stg + r32 * OST_ROWB + (32 * d0 + 8 * g + 4 * hi) * 2) = w; } }
    asm volatile("s_waitcnt lgkmcnt(0)" ::: "memory");
    f32x4 cw[3][2];
#pragma unroll
    for (int k = 0; k < 3; ++k) { cw[k][0] = *(const GAS f32x4*)(F.conv_w + k * D + colg); cw[k][1] = *(const GAS f32x4*)(F.conv_w + k * D + colg + 4); }
    float uf[6][8];
#pragma unroll
    for (int j = 0; j < 6; ++j) unpack8(uv[j], uf[j]);
    if (tb < 2) {
        if (ud.sample) { const float* sp = F.state_conv + (size_t)((ud.row0 - MP) / DEC_T * 2) * D + colg;
#pragma unroll
            for (int j = 0; j < 2; ++j) if (tb + j - 2 < 0) { const int pr = 2 + (tb + j - 2); const f32x4 a = *(const GAS f32x4*)(sp + (size_t)pr * D), b = *(const GAS f32x4*)(sp + (size_t)pr * D + 4);
                uf[j][0] = a.x; uf[j][1] = a.y; uf[j][2] = a.z; uf[j][3] = a.w; uf[j][4] = b.x; uf[j][5] = b.y; uf[j][6] = b.z; uf[j][7] = b.w; } }
        else {
#pragma unroll
            for (int j = 0; j < 2; ++j) if (tb + j - 2 < 0) {
#pragma unroll
                for (int e = 0; e < 8; ++e) uf[j][e] = 0.f; } }
    }
#pragma unroll
    for (int k = 0; k < 4; ++k) {
        const v4u ya = *(const LAS v4u*)(stg + (4 * rb + k) * OST_ROWB + ch * 16);
        float yv[8], sv[8], bv[8];
        unpack8(ya, yv); unpack8b(sgv[k], sv); unpack8(bgv[k], bv);
        float mo[8];
#pragma unroll
        for (int e = 0; e < 8; ++e) {
            const float conv = cw[0][e >> 2][e & 3] * uf[k][e] + cw[1][e >> 2][e & 3] * uf[k + 1][e] + cw[2][e >> 2][e & 3] * uf[k + 2][e];
            mo[e] = bv[e] * conv + sv[e] * yv[e];
        }
        v4u w; w.x = cvtpk(mo[0], mo[1]); w.y = cvtpk(mo[2], mo[3]); w.z = cvtpk(mo[4], mo[5]); w.w = cvtpk(mo[6], mo[7]);
        if (lane_on) *(GAS v4u*)(mgbase + (rowb + k) * D + colg) = w;
    }
}

template <int MODE = 0>
__device__ __forceinline__ void attn_phase(Frame& F, bool prompt, bool sample, int tix, int nteam, bf16* mgs, bf16* mgp) {
    constexpr int NPU = NB * 4 * NCH;
    UnitList L; L.p0 = 0; L.np = 0; L.s0 = tix; L.ns = 0; L.sstride = nteam;
    if (prompt) { const int per = (NPU + F.G - 1) / F.G; L.p0 = F.vcu * per; L.np = NPU - L.p0 < per ? (NPU - L.p0 > 0 ? NPU - L.p0 : 0) : per;
        if (F.G == 256) { const int x = (int)blockIdx.x & 7, j = (int)blockIdx.x >> 3; L.p0 = (((x >> 1) * 4 + (j & 3)) * NCH) + 64 * (x & 1) + 4 * (j >> 2); L.p1 = L.p0 + 32; L.np = 8; } }
    if (sample && tix < DEC_B * 4) L.ns = (DEC_B * 4 - tix + nteam - 1) / nteam;
    const int n = L.np + L.ns; if (n == 0) return;
    if (F.wave == 0) { float a = fabsf(F.q_norm_w[F.lane]), b = fabsf(F.k_norm_w[F.lane]), c = fabsf(F.sinks[F.lane & 15]) * 1.4426950408889634f;
#pragma unroll
      for (int o = 1; o < 64; o <<= 1) { a = fmaxf(a, __shfl_xor(a, o)); b = fmaxf(b, __shfl_xor(b, o)); c = fmaxf(c, __shfl_xor(c, o)); }
      if (F.lane == 0) *(LAS int*)(F.lds + RING_OFF + LDS_TOTAL2) = (64.f * pg8::QSCALE * a * b * 1.02f <= 60.f && c <= 60.f) ? 1 : 0; }
    UnitDesc ud; bf16x8 qr[4], qn[4];
    make_unit(F, L, 0, ud); issue_kv(F, ud, 0); load_q(q_addr(F, ud), qr);
    for (int i = 0; i < n; ++i) {
        __syncthreads();
        const int setoff = (i & 1) * SET_BYTES;
        const bf16* qnp = nullptr;
        if (i + 1 < n) { make_unit(F, L, i + 1, ud); issue_kv(F, ud, SET_BYTES - setoff); qnp = q_addr(F, ud); }
        make_unit(F, L, i, ud);
        compute_unit<MODE>(F, ud, setoff, qr, i < L.np ? mgp : mgs, qnp, qn);
#pragma unroll
        for (int d0 = 0; d0 < 4; ++d0) qr[d0] = qn[d0];
    }
    __syncthreads();
}
}


__device__ __forceinline__ void stage_signal(gu32* cnt) {
    asm volatile("s_waitcnt vmcnt(0)" ::: "memory"); __syncthreads();
    if (threadIdx.x == 0) { __builtin_amdgcn_fence(__ATOMIC_RELEASE, "agent"); asm volatile("s_waitcnt vmcnt(0)" ::: "memory"); __hip_atomic_fetch_add(cnt, 1u, RLX_AGENT); }
}
__device__ __forceinline__ void stage_wait(gu32* cnt, unsigned target) {
    if (threadIdx.x == 0) {
        unsigned sp = 0; while (__hip_atomic_load(cnt, RLX_AGENT) < target) { __builtin_amdgcn_s_sleep(2); if (++sp > (1u << 21)) break; }
        __builtin_amdgcn_fence(__ATOMIC_ACQUIRE, "agent"); asm volatile("s_waitcnt vmcnt(0)" ::: "memory");
    }
    __syncthreads();
}
constexpr int TEAM = 32;
constexpr int CW_TEAM = 3072;
struct Args { const float* in[16]; float* out; unsigned char* ws; };
__global__ void __launch_bounds__(NWAVES * 64, 2) mk_fwd(Args args) {
    extern __shared__ __attribute__((aligned(16))) unsigned char lds[];
    Frame F;
    F.lds = (LAS unsigned char*)lds;
    F.MISC = (volatile LAS unsigned*)(F.lds + MISC_OFF);
    F.tid = threadIdx.x; F.lane = F.tid & 63; F.wave = __builtin_amdgcn_readfirstlane(F.tid >> 6);
    F.G = gridDim.x; { const int bx = blockIdx.x; F.vcu = (F.G % 8 == 0) ? (bx % 8) * (F.G / 8) + bx / 8 : bx; }
    unsigned char* ws = args.ws;
    F.ctl = (gu32*)(ws + WS_CTL);
    F.xp = args.in[0]; F.xs = args.in[1]; F.state_conv = args.in[2]; F.cache_k = args.in[3]; F.cache_v = args.in[4]; F.norm_mix_w = args.in[5]; F.w_in = args.in[6]; F.conv_w = args.in[7];
    F.q_norm_w = args.in[8]; F.k_norm_w = args.in[9]; F.sinks = args.in[10]; F.w_out = args.in[11]; F.norm_ffn_w = args.in[12]; F.w_gate = args.in[13]; F.w_up = args.in[14]; F.w_down = args.in[15];
    F.out = args.out;
    F.Win_t = (bf16*)(ws + WS_WIN); F.Wout_t = (bf16*)(ws + WS_WOUT); F.Wgu_t = (bf16*)(ws + WS_WGU); F.Wd_t = (bf16*)(ws + WS_WD);
    F.XN = (bf16*)(ws + WS_XN);
    F.MG = (bf16*)(ws + WS_BG);
    F.Q = (bf16*)(ws + WS_Q); F.X1B = (bf16*)(ws + WS_Q); F.KB = (bf16*)(ws + WS_K); F.VB = (bf16*)(ws + WS_V);
    F.U = (bf16*)(ws + WS_U); F.BG = (bf16*)(ws + WS_BG); F.SG = (bf16*)(ws + WS_SG); F.H = (bf16*)(ws + WS_H); F.CK = (bf16*)(ws + WS_CK); F.CV = (bf16*)(ws + WS_CV);
    F.SS = (float*)(ws + WS_SS); F.IR = (float*)(ws + WS_IR);
    for (int u = F.tid; u < (LDS_BYTES - LDSCTL_OFF) / 4; u += NWAVES * 64) ((LAS unsigned*)(F.lds + LDSCTL_OFF))[u] = 0u;
    __syncthreads();
    XcdBarrier bar; bar.bar = (unsigned*)(F.ctl + CW_BAR); bar.x = 0; bar.st = nullptr;
    bar = xcd_barrier_post((unsigned*)(F.ctl + CW_BAR), F.MISC + 8);
#define GRID_BAR() xcd_barrier(bar)

#ifndef DEFER_W
#define DEFER_W 1
#endif
    p0_prologue(F, DEFER_W && gridDim.x == 256);
    GRID_BAR();
    const int tix = (int)blockIdx.x; const bool use_team = (F.G == 256); const bool team = use_team && tix < TEAM;
    const int MPR = use_team ? MP : MROWS;
    bf16* const Hs = (bf16*)(ws + WS_HS) - (size_t)MP * DFF;
    bf16* const MGs = (bf16*)(ws + WS_MGS) - (size_t)MP * D;
#define RUN_IN(S_)  do { pg8::Gemm g{F.XN, F.Win_t, MROWS, NIN, D}; pg8::EpiIn E{ws, F.q_norm_w, F.k_norm_w, F.out}; pg8::gemm_phase<pg8::EpiIn, pg8::Order, KN_ALIGN, KN_SP2>(F.lds + RING_OFF, g, S_, E); } while (0)
#define RUN_OUT(S_, MG_) do { pg8::Gemm g{MG_, F.Wout_t, MROWS, D, D}; pg8::EpiOut E{F.XN, F.IR, F.norm_mix_w, F.X1B, F.SS, (PG8_LAS float*)(F.lds + RING_BYTES)}; pg8::gemm_phase<pg8::EpiOut, pg8::Order, KN_ALIGN, KN_SP2, AUX_OUT>(F.lds + RING_OFF, g, S_, E); } while (0)
#define RUN_GU(S_, H_) RUN_GU_M(S_, H_, -1, -1)
#define RUN_GU_M(S_, H_, AM_, BM_)   do { pg8::Gemm g{F.X1B, F.Wgu_t, MROWS, NGU, D, AM_, BM_}; pg8::EpiGU E{F.SS, H_}; pg8::gemm_phase<pg8::EpiGU, pg8::Order, KN_ALIGN_GU, KN_SP2>(F.lds + RING_OFF, g, S_, E); } while (0)
#define RUN_DOWN(S_, H_) do { pg8::Gemm g{H_, F.Wd_t, MROWS, D, DFF}; pg8::EpiDown E{F.out + pg8::OUT_Y, F.X1B}; pg8::gemm_phase<pg8::EpiDown, pg8::Order, KN_ALIGN_DN, KN_SP2, AUX_DN>(F.lds + RING_OFF, g, S_, E); } while (0)
#ifndef KN_ALIGN
#define KN_ALIGN true
#endif
#ifndef KN_ALIGN_GU
#define KN_ALIGN_GU KN_ALIGN
#endif
#ifndef KN_ALIGN_DN
#define KN_ALIGN_DN KN_ALIGN
#endif
#ifndef AUX_DN
#define AUX_DN 0
#endif
#ifndef AUX_OUT
#define AUX_OUT 0
#endif
#ifndef KN_SP2
#define KN_SP2 true
#endif
#ifndef REV_DOWN
#define REV_DOWN 1
#endif
#define TEAM_CHAIN() do { gu32* const c1 = F.ctl + CW_TEAM, * const c2 = c1 + 64, * const c3 = c1 + 128, * const c4 = c1 + 192, * const w1 = c1 + 256, * const w2 = c1 + 320; pg8::Order S; \
          \
        if (tix < 26) { S.panel(128, NIN, tix, TEAM); RUN_IN(S); stage_signal(c1); } \
        else { if (DEFER_W) p0_weight_items(F, I_IN, I_O, tix - 26, TEAM - 26); stage_signal(w1); } \
        stage_wait(c1, 26); p2::attn_phase(F, false, true, tix, TEAM, MGs, F.MG); stage_signal(c2); \
        if (tix < 4) { stage_wait(c2, TEAM); stage_wait(w1, TEAM - 26); S.panel(128, D, tix, TEAM); RUN_OUT(S, MGs); stage_signal(c3); } \
        else if (tix < 24 || tix >= 28) { if (DEFER_W) p0_weight_items(F, I_IN + I_O, 2 * I_G + I_D, tix < 24 ? tix - 4 : tix - 8, TEAM - 8); stage_signal(w2); }     \
        if (tix < 22) { stage_wait(c3, 4); stage_wait(w2, TEAM - 8); S.panel(128, NGU, tix, TEAM); RUN_GU(S, Hs); stage_signal(c4); } \
        if (tix < 4) { stage_wait(c4, 22); S.panel(128, D, tix, TEAM); RUN_DOWN(S, Hs); } } while (0)
#define PROMPT_IN() do { pg8::Order S; \
        if (!use_team) S.grid(MROWS, NIN, tix, F.G, 1 << 30); \
        else if (team) {   \
            const int r = tix & 7, q = tix >> 3; const bool heavy = r < 4; \
            const int share = heavy ? (q == 0 ? 2 : (q == 3 ? 10 : 6)) : 6, first = heavy ? (q == 0 ? 0 : (q == 1 ? 2 : (q == 2 ? 8 : 14))) : 6 * q; \
            S.grid(MP, NIN, (F.G - TEAM) * 14 + r + 8 * first, 8, share); } \
        else S.grid(MP, NIN, tix - TEAM, F.G - TEAM, 14); \
        RUN_IN(S); } while (0)
    if (team) TEAM_CHAIN();
    PROMPT_IN(); GRID_BAR();
    {
        pg8::Order S;
        p2::attn_phase(F, true, !use_team, tix, F.G, F.MG, F.MG); GRID_BAR();
        S.grid(MPR, D, tix, F.G, 1 << 30);   RUN_OUT(S, F.MG); GRID_BAR();
        S.grid(MPR, NGU, tix, F.G, 1 << 30); RUN_GU(S, F.H);
        GRID_BAR();
        S.grid(MPR, D, tix, F.G, 1 << 30, REV_DOWN);   RUN_DOWN(S, F.H);
    }
}

extern "C" void kernel_launch(void* const* d_in, const int* in_sizes, int n_in, void* d_out, int out_size, void* d_ws, size_t ws_size, hipStream_t stream) {
    static int grid = 0;
    if (grid == 0) {
        if (n_in != 16 || in_sizes[0] != MP * D || (size_t)out_size != pg8::OUT_TOTAL || ws_size < WS_END + WS_BASE) {
            fprintf(stderr, "kernel_launch: shape mismatch: n_in %d in0 %d out %d ws %zu (need %zu); nothing launched\n", n_in, n_in > 0 ? in_sizes[0] : -1, out_size, ws_size, (size_t)WS_END); grid = -1; return; }
        int dev = 0, cus = 0, per_cu = 0;
        if (hipGetDevice(&dev) != hipSuccess || hipDeviceGetAttribute(&cus, hipDeviceAttributeMultiprocessorCount, dev) != hipSuccess) { fprintf(stderr, "kernel_launch: device query failed\n"); grid = -1; return; }
        if (hipFuncSetAttribute((const void*)mk_fwd, hipFuncAttributeMaxDynamicSharedMemorySize, LDS_BYTES) != hipSuccess) { fprintf(stderr, "kernel_launch: hipFuncSetAttribute failed\n"); grid = -1; return; }
        if (hipOccupancyMaxActiveBlocksPerMultiprocessor(&per_cu, (const void*)mk_fwd, NWAVES * 64, LDS_BYTES) != hipSuccess || per_cu < 1) { fprintf(stderr, "kernel_launch: occupancy query reports %d blocks per CU\n", per_cu); (void)hipGetLastError(); per_cu = 1; }
        grid = cus;
        if (grid % 8 != 0) grid -= grid % 8;
    }
    if (grid < 0) return;
    if (hipMemsetAsync((char*)d_ws + WS_BASE + WS_CTL, 0, CTL_ZERO_BYTES, stream) != hipSuccess) { fprintf(stderr, "kernel_launch: memset failed\n"); return; }
    Args a{};
    for (int i = 0; i < 16; ++i) a.in[i] = (const float*)d_in[i];
    a.out = (float*)d_out; a.ws = (unsigned char*)d_ws + WS_BASE;
    hipLaunchKernelGGL(mk_fwd, dim3(grid), dim3(NWAVES * 64), LDS_BYTES, stream, a);
    const hipError_t le = hipPeekAtLastError();
    if (le != hipSuccess) fprintf(stderr, "kernel_launch: launch failed: %s\n", hipGetErrorName(le));
}
```
